# Optimizing an MI355X kernel written in HIP

```python
import math
import jax, jax.numpy as jnp
from jax import lax
import numpy as np

D_MODEL = 2048
BATCH = 8
SEQ = 2048
DEPTH = 2

N_MEM = 256
HEAD_DIM = 128
MIX_HEADS = 12
MIX_WIDTH = MIX_HEADS * HEAD_DIM
MEM_HEADS = 4
MEM_WIDTH = MEM_HEADS * HEAD_DIM
DIFF_QK_DIM = HEAD_DIM // 2
ROPE_THETA = 10000.0
Q_BLOCK = 128
MLSTM_CHUNK = 128
PEER_HEADS = 8
PEER_NKEYS = 128
PEER_NEXPERTS = PEER_NKEYS * PEER_NKEYS
PEER_QDIM = 256
PEER_SUBK = PEER_QDIM // 2
PEER_TOPK = 16
PEER_TOKEN_BLOCK = 128
N_MIXERS = 2
N_ATTN_LAYERS = (DEPTH + 1) // 2
N_MLSTM_LAYERS = DEPTH // 2
DN_ALPHA = (2.0 * DEPTH) ** 0.25
DN_BETA = (8.0 * DEPTH) ** -0.25
LN_EPS = 1e-5
ATTN_IN = 3 * MIX_WIDTH + MEM_WIDTH
MLSTM_IN = 4 * MIX_WIDTH + MEM_WIDTH + 4 * MIX_HEADS

kernel_name = "hybrid_diffattn_mlstm_peer_encoder"

F32 = jnp.float32


def layer_norm(x, g, b):
    xf = x.astype(F32)
    mu = xf.mean(-1, keepdims=True)
    var = jnp.square(xf - mu).mean(-1, keepdims=True)
    return ((xf - mu) * lax.rsqrt(var + LN_EPS)).astype(x.dtype) * g + b


def head_rms_norm(h, g):
    hf = h.astype(F32)
    return hf * lax.rsqrt(jnp.mean(hf * hf, -1, keepdims=True) + LN_EPS) * g.astype(F32)


def rope(t, positions):
    d = t.shape[-1]
    half = d // 2
    inv = jnp.power(ROPE_THETA, -jnp.arange(half, dtype=F32) * (2.0 / d))
    ang = positions.astype(F32)[..., None] * inv
    ang = ang.reshape(ang.shape[:2] + (1,) * (t.ndim - 3) + (half,))
    cos, sin = jnp.cos(ang), jnp.sin(ang)
    tf = t.astype(F32)
    t1, t2 = tf[..., :half], tf[..., half:]
    return jnp.concatenate([t1 * cos - t2 * sin, t2 * cos + t1 * sin], -1).astype(t.dtype)


def blocked_diff_attention(q, k, v, lam):
    B, S, H, _, dq = q.shape
    nb = S // Q_BLOCK
    scale = dq ** -0.5
    qb = jnp.moveaxis(q.reshape(B, nb, Q_BLOCK, H, 2, dq), 1, 0)

    def block(qblk):
        s = jnp.einsum('bqhmd,bkhmd->bhmqk', qblk, k).astype(F32) * scale
        p = jax.nn.softmax(s, axis=-1)
        a = p[:, :, 0] - lam * p[:, :, 1]
        return jnp.einsum('bhqk,bkhd->bqhd', a.astype(v.dtype), v)

    out = lax.map(block, qb)
    return jnp.moveaxis(out, 0, 1).reshape(B, S, H, v.shape[-1])


def diff_attention_mixer(q, k, v, positions, lam_params, norm_g, lam_init):
    B, S, _ = q.shape
    qh = rope(q.reshape(B, S, MIX_HEADS, 2, DIFF_QK_DIM), positions)
    kh = rope(k.reshape(B, S, MIX_HEADS, 2, DIFF_QK_DIM), positions)
    vh = v.reshape(B, S, MIX_HEADS, HEAD_DIM)
    lp = lam_params.astype(F32)
    lam = jnp.exp(jnp.sum(lp[0] * lp[1])) - jnp.exp(jnp.sum(lp[2] * lp[3])) + lam_init
    out = blocked_diff_attention(qh, kh, vh, lam)
    out = head_rms_norm(out, norm_g) * (1.0 - lam_init)
    return out.reshape(B, S, MIX_WIDTH).astype(q.dtype)


def mlstm_scan(q, k, v, ig, lf):
    B, H, S, d = q.shape
    L = MLSTM_CHUNK
    nc = S // L
    qc = q.reshape(B, H, nc, L, d)
    kc = k.reshape(B, H, nc, L, d)
    vc = v.reshape(B, H, nc, L, d)
    igc = ig.reshape(B, H, nc, L)
    b = jnp.cumsum(lf.reshape(B, H, nc, L), axis=-1)
    b_last = b[..., -1]
    a = b_last[..., None] - b + igc
    a_max = a.max(-1)
    wa = jnp.exp(a - a_max[..., None])
    kw = kc * wa[..., None]
    kv_chunk = jnp.einsum('bhcsk,bhcsv->bhckv', kw, vc)
    k_chunk = kw.sum(3)

    def step(carry, inp):
        C, n, m = carry
        bl, am, kvc, kcs = inp
        m_new = jnp.maximum(bl + m, am)
        decay = jnp.exp(bl + m - m_new)
        w = jnp.exp(am - m_new)
        C_new = decay[..., None, None] * C + w[..., None, None] * kvc
        n_new = decay[..., None] * n + w[..., None] * kcs
        return (C_new, n_new, m_new), (C, n, m)

    init = (jnp.zeros((B, H, d, d), F32), jnp.zeros((B, H, d), F32), jnp.zeros((B, H), F32))
    xs = (jnp.moveaxis(b_last, 2, 0), jnp.moveaxis(a_max, 2, 0),
          jnp.moveaxis(kv_chunk, 2, 0), jnp.moveaxis(k_chunk, 2, 0))
    _, (C_s, n_s, m_s) = lax.scan(step, init, xs)
    C_s = jnp.moveaxis(C_s, 0, 2)
    n_s = jnp.moveaxis(n_s, 0, 2)
    m_s = jnp.moveaxis(m_s, 0, 2)

    mask = jnp.tril(jnp.ones((L, L), dtype=bool))
    Dm = b[..., :, None] - b[..., None, :] + igc[..., None, :]
    Dm = jnp.where(mask, Dm, -jnp.inf)
    inter = b + m_s[..., None]
    m_j = jnp.maximum(inter, Dm.max(-1))
    Wd = jnp.exp(Dm - m_j[..., None])
    wi = jnp.exp(inter - m_j)
    qk = jnp.einsum('bhcjd,bhcsd->bhcjs', qc, kc) * Wd
    num = wi[..., None] * jnp.einsum('bhcjk,bhckv->bhcjv', qc, C_s) + jnp.einsum('bhcjs,bhcsv->bhcjv', qk, vc)
    den = wi * jnp.einsum('bhcjk,bhck->bhcj', qc, n_s) + qk.sum(-1)
    h = num / jnp.maximum(jnp.abs(den), jnp.exp(-m_j))[..., None]
    return h.reshape(B, H, S, d)


def mlstm_mixer(q, k, v, o, gates, gate_bias, norm_g):
    B, S, _ = q.shape

    def heads(t):
        return t.reshape(B, S, MIX_HEADS, HEAD_DIM).transpose(0, 2, 1, 3).astype(F32)

    qh, kh, vh = heads(q), heads(k) * (HEAD_DIM ** -0.5), heads(v)
    g = (gates.astype(F32).reshape(B, S, 4, MIX_HEADS) + gate_bias.astype(F32)).transpose(0, 2, 3, 1)
    ig_f, lf_f = g[:, 0], jax.nn.log_sigmoid(g[:, 1])
    ig_b, lf_b = g[:, 2], jax.nn.log_sigmoid(g[:, 3])
    h_f = mlstm_scan(qh, kh, vh, ig_f, lf_f)
    rev = lambda t: jnp.flip(t, axis=2)
    h_b = rev(mlstm_scan(rev(qh), rev(kh), rev(vh), rev(ig_b), rev(lf_b)))
    hs = head_rms_norm((h_f + h_b).transpose(0, 2, 1, 3), norm_g)
    out = jax.nn.sigmoid(o.astype(F32)).reshape(B, S, MIX_HEADS, HEAD_DIM) * hs
    return out.reshape(B, S, MIX_WIDTH).astype(q.dtype)


def memory_attention(qm, mem_k, mem_v):
    s = jnp.einsum('bshd,bmhd->bhsm', qm, mem_k).astype(F32) * (HEAD_DIM ** -0.5)
    p = jax.nn.softmax(s, axis=-1)
    return jnp.einsum('bhsm,bmhd->bshd', p.astype(mem_v.dtype), mem_v)


def peer_ffn(x, w_query, sub_keys, u_tab, v_tab):
    B, S, D = x.shape
    T = B * S
    xt = x.reshape(T, D)
    qry = (xt @ w_query).reshape(T, PEER_HEADS, 2, PEER_SUBK)
    s = jnp.einsum('thps,hpns->thpn', qry, sub_keys).astype(F32)
    sv, si = lax.top_k(s, PEER_TOPK)
    cand = (sv[:, :, 0, :, None] + sv[:, :, 1, None, :]).reshape(T, PEER_HEADS, PEER_TOPK * PEER_TOPK)
    cidx = (si[:, :, 0, :, None] * PEER_NKEYS + si[:, :, 1, None, :]).reshape(T, PEER_HEADS, PEER_TOPK * PEER_TOPK)
    top_s, pos = lax.top_k(cand, PEER_TOPK)
    eidx = jnp.take_along_axis(cidx, pos, axis=-1)
    gate = jax.nn.softmax(top_s, axis=-1)
    nb = T // PEER_TOKEN_BLOCK

    def block(args):
        xb, eb, gb = args
        act = jax.nn.gelu(jnp.einsum('thkd,td->thk', u_tab[eb], xb).astype(F32), approximate=False)
        w = (gb * act).astype(xb.dtype)
        return jnp.einsum('thk,thkd->td', w, v_tab[eb])

    out = lax.map(block, (xt.reshape(nb, PEER_TOKEN_BLOCK, D),
                          eidx.reshape(nb, PEER_TOKEN_BLOCK, PEER_HEADS, PEER_TOPK),
                          gate.reshape(nb, PEER_TOKEN_BLOCK, PEER_HEADS, PEER_TOPK)))
    return out.reshape(B, S, D)


def setup_inputs(seed: int = 0) -> dict:
    key = jax.random.key(seed)
    ks = jax.random.split(key, 24)
    D = D_MODEL
    nrm = lambda k, shape, sc: jax.random.normal(k, shape, F32) * sc
    x = nrm(ks[0], (BATCH, SEQ, D), 1.0)
    mem = nrm(ks[1], (BATCH, N_MEM, D), 1.0)
    positions = jnp.broadcast_to(jnp.arange(SEQ, dtype=jnp.int32)[None, :], (BATCH, SEQ))
    attn_w_in = nrm(ks[2], (N_ATTN_LAYERS, D, ATTN_IN), D ** -0.5)
    attn_lambda = nrm(ks[3], (N_ATTN_LAYERS, 4, DIFF_QK_DIM), 0.1)
    attn_head_norm = 1.0 + nrm(ks[4], (N_ATTN_LAYERS, MIX_HEADS, HEAD_DIM), 0.02)
    mlstm_w_in = nrm(ks[5], (N_MLSTM_LAYERS, D, MLSTM_IN), D ** -0.5)
    noise = nrm(ks[6], (N_MLSTM_LAYERS, 4, MIX_HEADS), 0.1)
    f_base = jnp.linspace(3.0, 6.0, MIX_HEADS, dtype=F32)
    base = jnp.stack([jnp.zeros_like(f_base), f_base, jnp.zeros_like(f_base), f_base])[None]
    mlstm_gate_bias = base + noise
    mlstm_head_norm = 1.0 + nrm(ks[7], (N_MLSTM_LAYERS, MIX_HEADS, HEAD_DIM), 0.02)
    mem_w_kv = nrm(ks[8], (D, 2 * MEM_WIDTH), D ** -0.5)
    w_out = nrm(ks[9], (DEPTH, MIX_WIDTH + MEM_WIDTH, D), DN_BETA * (MIX_WIDTH + MEM_WIDTH) ** -0.5)
    ln_mix_g = 1.0 + nrm(ks[10], (DEPTH, D), 0.02)
    ln_mix_b = nrm(ks[11], (DEPTH, D), 0.02)
    peer_w_query = nrm(ks[12], (DEPTH, D, PEER_HEADS * PEER_QDIM), D ** -0.5)
    peer_sub_keys = nrm(ks[13], (DEPTH, PEER_HEADS, 2, PEER_NKEYS, PEER_SUBK), PEER_SUBK ** -0.5)
    peer_u = nrm(ks[14], (DEPTH, PEER_NEXPERTS, D), D ** -0.5)
    peer_v = nrm(ks[15], (DEPTH, PEER_NEXPERTS, D), DN_BETA * PEER_HEADS ** -0.5)
    ln_ffn_g = 1.0 + nrm(ks[16], (DEPTH, D), 0.02)
    ln_ffn_b = nrm(ks[17], (DEPTH, D), 0.02)
    return {"x": x, "mem": mem, "positions": positions,
            "attn_w_in": attn_w_in, "attn_lambda": attn_lambda, "attn_head_norm": attn_head_norm,
            "mlstm_w_in": mlstm_w_in, "mlstm_gate_bias": mlstm_gate_bias, "mlstm_head_norm": mlstm_head_norm,
            "mem_w_kv": mem_w_kv, "w_out": w_out, "ln_mix_g": ln_mix_g, "ln_mix_b": ln_mix_b,
            "peer_w_query": peer_w_query, "peer_sub_keys": peer_sub_keys, "peer_u": peer_u, "peer_v": peer_v,
            "ln_ffn_g": ln_ffn_g, "ln_ffn_b": ln_ffn_b}


def reference(x, mem, positions, attn_w_in, attn_lambda, attn_head_norm, mlstm_w_in, mlstm_gate_bias,
              mlstm_head_norm, mem_w_kv, w_out, ln_mix_g, ln_mix_b, peer_w_query, peer_sub_keys, peer_u, peer_v,
              ln_ffn_g, ln_ffn_b):
    B, S, D = x.shape
    M = mem.shape[1]
    mem_kv = (mem @ mem_w_kv).reshape(B, M, 2, MEM_HEADS, HEAD_DIM)
    mem_k, mem_v = mem_kv[:, :, 0], mem_kv[:, :, 1]
    h = x
    for i in range(DEPTH):
        j = i // N_MIXERS
        if i % N_MIXERS == 0:
            proj = h @ attn_w_in[j]
            q, k, v, qm = jnp.split(proj, [MIX_WIDTH, 2 * MIX_WIDTH, 3 * MIX_WIDTH], axis=-1)
            lam_init = 0.8 - 0.6 * math.exp(-0.3 * i)
            mix = diff_attention_mixer(q, k, v, positions, attn_lambda[j], attn_head_norm[j], lam_init)
        else:
            proj = h @ mlstm_w_in[j]
            q, k, v, o, qm, gates = jnp.split(
                proj, [MIX_WIDTH, 2 * MIX_WIDTH, 3 * MIX_WIDTH, 4 * MIX_WIDTH, 4 * MIX_WIDTH + MEM_WIDTH], axis=-1)
            mix = mlstm_mixer(q, k, v, o, gates, mlstm_gate_bias[j], mlstm_head_norm[j])
        mem_out = memory_attention(qm.reshape(B, S, MEM_HEADS, HEAD_DIM), mem_k, mem_v).reshape(B, S, MEM_WIDTH)
        y = jnp.concatenate([mix, mem_out], axis=-1) @ w_out[i]
        h = layer_norm(DN_ALPHA * h + y, ln_mix_g[i], ln_mix_b[i])
        f = peer_ffn(h, peer_w_query[i], peer_sub_keys[i], peer_u[i], peer_v[i])
        h = layer_norm(DN_ALPHA * h + f, ln_ffn_g[i], ln_ffn_b[i])
    return h
```

```cpp
#include <hip/hip_runtime.h>
#include <hip/hip_cooperative_groups.h>
#include <cstdio>
#include <cstdint>
namespace cg = cooperative_groups;

typedef unsigned short bf16;
typedef __attribute__((ext_vector_type(8))) short bf16x8;
typedef __attribute__((ext_vector_type(16))) float f32x16;
#define DEV __device__ __forceinline__

constexpr int NT = 512;
constexpr int T_ = 16384, D_ = 2048, S_ = 2048, B_ = 8;
constexpr int PLD = 5120;
constexpr int NMLPAD = 6912;
constexpr size_t LDS_BYTES = 147456;
constexpr float DN_ALPHA = 1.4142135623730951f;
constexpr float LN_EPS = 1e-5f;
constexpr int NPHASE = 15;

struct Params {
  const float *x, *mem; const int* pos;
  const float *attn_w, *attn_lam, *attn_hn, *ml_w, *ml_gb, *ml_hn, *memkv_w, *w_out, *ln_mix_g, *ln_mix_b,
      *wq, *subk, *pu, *pv, *ln_ffn_g, *ln_ffn_b;
  float* out;
  unsigned char* tab;
  bf16* ybf;
  bf16 *WtAttn, *WtMl, *WtMemkv, *WtOut, *WtQ, *SK, *membf, *hbf, *proj, *Vt, *memK, *memVt;
  float *hf, *gates, *sv, *nvec, *scal, *mst, *tsc;
  bf16* kvT;
  int* si;
  unsigned* bar;
  int ph_lo, ph_hi;
};

DEV bf16 f2bf(float f) { uint32_t u = __float_as_uint(f); u += 0x7fffu + ((u >> 16) & 1u); return (bf16)(u >> 16); }
DEV float bf2f(bf16 h) { return __uint_as_float(((uint32_t)h) << 16); }
typedef __attribute__((ext_vector_type(2))) __bf16 bf16v2_t;
typedef __attribute__((ext_vector_type(2))) float f32v2_t;
DEV uint32_t pack2(float a, float b) { f32v2_t x = {a, b}; return __builtin_bit_cast(uint32_t, __builtin_convertvector(x, bf16v2_t)); }
DEV float bflo(uint32_t u) { return __uint_as_float(u << 16); }
DEV float bfhi(uint32_t u) { return __uint_as_float(u & 0xffff0000u); }
DEV f32x16 mfma32(bf16x8 a, bf16x8 b, f32x16 c) { return __builtin_amdgcn_mfma_f32_32x32x16_bf16(a, b, c, 0, 0, 0); }
DEV f32x16 zero16() { f32x16 z; for (int i = 0; i < 16; ++i) z[i] = 0.f; return z; }
DEV float wave_sum(float v) { for (int o = 32; o > 0; o >>= 1) v += __shfl_xor(v, o); return v; }
DEV float wave_max(float v) { for (int o = 32; o > 0; o >>= 1) v = fmaxf(v, __shfl_xor(v, o)); return v; }
DEV bf16x8 ld8(const bf16* p) { return *(const bf16x8*)p; }
typedef __attribute__((ext_vector_type(4))) uint32_t u32x4;
DEV bf16x8 mk8(uint32_t a, uint32_t b, uint32_t c, uint32_t d) {
  u32x4 t = {a, b, c, d}; return __builtin_bit_cast(bf16x8, t);
}

DEV void conv_transpose_tile(const float* __restrict__ src, int N, bf16* __restrict__ dst, int tile, char* smem) {
  float* tl = (float*)smem;
  const int nt = tile >> 5, kt = tile & 31, tid = threadIdx.x;
  __syncthreads();
  for (int ps = 0; ps < 8; ++ps) {
    int r = ps * 8 + (tid >> 6), c = tid & 63;
    int n = nt * 64 + c;
    tl[r * 65 + c] = (n < N) ? src[(size_t)(kt * 64 + r) * N + n] : 0.f;
  }
  __syncthreads();
  for (int ps = 0; ps < 8; ++ps) {
    int n = ps * 8 + (tid >> 6), k = tid & 63;
    dst[(size_t)(nt * 64 + n) * 2048 + kt * 64 + k] = f2bf(tl[k * 65 + n]);
  }
}
DEV void conv_lin(const float* __restrict__ src, bf16* __restrict__ dst, size_t item) {
  size_t o = item * 4096 + (size_t)threadIdx.x * 8;
  float4 a = *(const float4*)(src + o), b = *(const float4*)(src + o + 4);
  uint4 r; r.x = pack2(a.x, a.y); r.y = pack2(a.z, a.w); r.z = pack2(b.x, b.y); r.w = pack2(b.z, b.w);
  *(uint4*)(dst + o) = r;
}
DEV void phase_convert(const Params& p, char* smem) {
  const int nTt = 2560 + 3456 + 512 + 2048 + 2048;
  for (int it = blockIdx.x; it < nTt; it += gridDim.x) {
    int t = it;
    if (t < 2560) { conv_transpose_tile(p.attn_w, 5120, p.WtAttn, t, smem); continue; } t -= 2560;
    if (t < 3456) { conv_transpose_tile(p.ml_w, 6704, p.WtMl, t, smem); continue; } t -= 3456;
    if (t < 512) { conv_transpose_tile(p.memkv_w, 1024, p.WtMemkv, t, smem); continue; } t -= 512;
    if (t < 2048) { int l = t >> 10; conv_transpose_tile(p.w_out + (size_t)l * 2048 * 2048, 2048, p.WtOut + (size_t)l * 2048 * 2048, t & 1023, smem); continue; } t -= 2048;
    { int l = t >> 10; conv_transpose_tile(p.wq + (size_t)l * 2048 * 2048, 2048, p.WtQ + (size_t)l * 2048 * 2048, t & 1023, smem); }
  }
  for (int it = blockIdx.x; it < 8192; it += gridDim.x) {
    const int lane = threadIdx.x & 63, row = it * 8 + (threadIdx.x >> 6);
    const int tbl = row >> 14, e = row & 16383, layer = tbl >> 1, which = tbl & 1;
    const float* sp = (which ? p.pv : p.pu) + ((size_t)layer * 16384 + e) * 2048 + lane * 4;
    float x[32];
    float m = 0.f;
#pragma unroll
    for (int c = 0; c < 8; ++c) {
      float4 a = *(const float4*)(sp + c * 256);
      x[c * 4] = a.x; x[c * 4 + 1] = a.y; x[c * 4 + 2] = a.z; x[c * 4 + 3] = a.w;
      m = fmaxf(m, fmaxf(fmaxf(fabsf(a.x), fabsf(a.y)), fmaxf(fabsf(a.z), fabsf(a.w))));
    }
    m = wave_max(m);
    const float inv = m > 0.f ? 6.f / m : 0.f;
    if (lane == 0) p.tsc[row] = m > 0.f ? m * (1.f / 6.f) : 0.f;
    uint32_t wv[4] = {0u, 0u, 0u, 0u};
#pragma unroll
    for (int k = 0; k < 32; ++k) {
      const float y = x[k] * inv, a = fabsf(y);
      float c = a < 2.f ? rintf(a * 2.f) : (a < 4.f ? 4.f + rintf(a - 2.f) : fminf(7.f, 6.f + rintf((a - 4.f) * 0.5f)));
      wv[k >> 3] |= ((uint32_t)c | (y < 0.f ? 8u : 0u)) << ((k & 7) * 4);
    }
    *(uint4*)(p.tab + (size_t)row * 1024 + lane * 16) = make_uint4(wv[0], wv[1], wv[2], wv[3]);
  }
  const int nL = 128 + 1024 + 8192;
  for (int it = blockIdx.x; it < nL; it += gridDim.x) {
    int t = it;
    if (t < 128) { conv_lin(p.subk, p.SK, t); continue; } t -= 128;
    if (t < 1024) { conv_lin(p.mem, p.membf, t); continue; } t -= 1024;
    conv_lin(p.x, p.hbf, t);
  }
}

enum { EPI_ATTN = 0, EPI_ML = 1, EPI_MEMKV = 2, EPI_OUT = 3, EPI_PEERQ = 4 };

template <int EPI>
DEV void epi64(const Params& p, int layer, int cb, int rb0, int l32, int hl, const f32x16& a00, const f32x16& a01, const f32x16& a10, const f32x16& a11) {
  f32x16 acc[2][2]; acc[0][0] = a00; acc[0][1] = a01; acc[1][0] = a10; acc[1][1] = a11;
  if constexpr (EPI == EPI_ATTN || EPI == EPI_ML) {
    int cls;
    float scale = 1.f; int dcol = 0;
    if constexpr (EPI == EPI_ATTN) {
      if (cb < 1536) { cls = 0; scale = 0.125f * 1.4426950408889634f; dcol = cb; }
      else if (cb < 3072) { cls = 1; dcol = cb; }
      else if (cb < 4608) { cls = 3; dcol = cb - 3072; }
      else { cls = 2; scale = 0.08838834764831845f * 1.4426950408889634f; dcol = cb - 4608 + 3072; }
    } else {
      if (cb < 1536) { cls = 2; dcol = cb; }
      else if (cb < 3072) { cls = 2; scale = 0.08838834764831845f; dcol = cb; }
      else if (cb < 4608) { cls = 3; dcol = cb - 3072; }
      else if (cb < 6144) { cls = 2; dcol = cb - 4608 + 3072; }
      else if (cb < 6656) { cls = 2; scale = 0.08838834764831845f * 1.4426950408889634f; dcol = cb - 6144 + 4608; }
      else if (cb < 6720) { cls = 4; }
      else cls = 5;
    }
    if (cls <= 1) {
      const float inv = exp2f(-(float)l32 * (13.287712379549449f / 32.f));
#pragma unroll
      for (int tm = 0; tm < 2; ++tm)
#pragma unroll
        for (int i = 0; i < 16; ++i) {
          int r = rb0 + tm * 32 + (i >> 2) * 8 + hl * 4 + (i & 3);
          float rev = (float)p.pos[r] * inv * 0.15915494309189535f;
          rev -= floorf(rev);
          float sn = __builtin_amdgcn_sinf(rev), cs = __builtin_amdgcn_cosf(rev);
          float t1 = acc[tm][0][i], t2 = acc[tm][1][i];
          p.proj[(size_t)r * PLD + dcol + l32] = f2bf((t1 * cs - t2 * sn) * scale);
          p.proj[(size_t)r * PLD + dcol + 32 + l32] = f2bf((t2 * cs + t1 * sn) * scale);
        }
    } else if (cls == 2) {
#pragma unroll
      for (int tm = 0; tm < 2; ++tm)
#pragma unroll
        for (int tn = 0; tn < 2; ++tn)
#pragma unroll
          for (int i = 0; i < 16; ++i) {
            int r = rb0 + tm * 32 + (i >> 2) * 8 + hl * 4 + (i & 3);
            p.proj[(size_t)r * PLD + dcol + tn * 32 + l32] = f2bf(acc[tm][tn][i] * scale);
          }
    } else if (cls == 3) {
#pragma unroll
      for (int tm = 0; tm < 2; ++tm)
#pragma unroll
        for (int tn = 0; tn < 2; ++tn) {
          int c = dcol + tn * 32 + l32; int hh = c >> 7, d = c & 127;
#pragma unroll
          for (int g = 0; g < 4; ++g) {
            int r = rb0 + tm * 32 + g * 8 + hl * 4; int b = r >> 11, s = r & 2047;
            uint2 v; v.x = pack2(acc[tm][tn][g * 4], acc[tm][tn][g * 4 + 1]); v.y = pack2(acc[tm][tn][g * 4 + 2], acc[tm][tn][g * 4 + 3]);
            *(uint2*)(p.Vt + ((size_t)(b * 12 + hh) * 128 + d) * 2048 + s) = v;
          }
        }
    } else if (cls == 4) {
      if (l32 < 24 || true) {
#pragma unroll
        for (int tm = 0; tm < 2; ++tm)
#pragma unroll
          for (int tn = 0; tn < 2; ++tn) {
            int c = tn * 32 + l32;
            if (c < 48) {
#pragma unroll
              for (int i = 0; i < 16; ++i) {
                int r = rb0 + tm * 32 + (i >> 2) * 8 + hl * 4 + (i & 3);
                p.gates[(size_t)r * 48 + c] = acc[tm][tn][i];
              }
            }
          }
      }
    }
  } else if constexpr (EPI == EPI_MEMKV) {
    if (cb < 512) {
#pragma unroll
      for (int tm = 0; tm < 2; ++tm)
#pragma unroll
        for (int tn = 0; tn < 2; ++tn)
#pragma unroll
          for (int i = 0; i < 16; ++i) {
            int r = rb0 + tm * 32 + (i >> 2) * 8 + hl * 4 + (i & 3);
            p.memK[(size_t)r * 512 + cb + tn * 32 + l32] = f2bf(acc[tm][tn][i]);
          }
    } else {
#pragma unroll
      for (int tm = 0; tm < 2; ++tm)
#pragma unroll
        for (int tn = 0; tn < 2; ++tn) {
          int c = cb - 512 + tn * 32 + l32; int hh = c >> 7, d = c & 127;
#pragma unroll
          for (int g = 0; g < 4; ++g) {
            int r = rb0 + tm * 32 + g * 8 + hl * 4; int b = r >> 8, s = r & 255;
            uint2 v; v.x = pack2(acc[tm][tn][g * 4], acc[tm][tn][g * 4 + 1]); v.y = pack2(acc[tm][tn][g * 4 + 2], acc[tm][tn][g * 4 + 3]);
            *(uint2*)(p.memVt + ((size_t)(b * 4 + hh) * 128 + d) * 256 + s) = v;
          }
        }
    }
  } else if constexpr (EPI == EPI_OUT) {
#pragma unroll
    for (int tm = 0; tm < 2; ++tm)
#pragma unroll
      for (int tn = 0; tn < 2; ++tn)
#pragma unroll
        for (int i = 0; i < 16; ++i) {
          int r = rb0 + tm * 32 + (i >> 2) * 8 + hl * 4 + (i & 3);
          p.ybf[(size_t)r * 2048 + cb + tn * 32 + l32] = f2bf(acc[tm][tn][i]);
        }
  }
}

template <int EPI>
DEV void gemm_tile(const Params& p, const bf16* __restrict__ A, const bf16* __restrict__ Bt, int m0, int n0, int layer, char* smem) {
  bf16* As = (bf16*)smem;
  bf16* Bs = As + 2 * 128 * 72;
  const int tid = threadIdx.x, lane = tid & 63, w = tid >> 6, wm = w >> 2, wn = w & 3, l32 = lane & 31, hl = lane >> 5;
  f32x16 acc[2][2];
  for (int a = 0; a < 2; ++a) for (int b = 0; b < 2; ++b) acc[a][b] = zero16();
  uint4 s0a0, s0a1, s0b0, s0b1, s0b2, s0b3, s1a0, s1a1, s1b0, s1b1, s1b2, s1b3, s2a0, s2a1, s2b0, s2b1, s2b2, s2b3, s3a0, s3a1, s3b0, s3b1, s3b2, s3b3;
  const int lr = tid >> 3, lc = (tid & 7) * 8;
  const bf16* Ap = A + (size_t)(m0 + lr) * 2048 + lc;
  const bf16* Bp = Bt + (size_t)(n0 + lr) * 2048 + lc;
#define G_LOAD(S, k0) { S##a0 = *(const uint4*)(Ap + (k0)); S##a1 = *(const uint4*)(Ap + (size_t)64 * 2048 + (k0)); \
    S##b0 = *(const uint4*)(Bp + (k0)); S##b1 = *(const uint4*)(Bp + (size_t)64 * 2048 + (k0)); S##b2 = *(const uint4*)(Bp + (size_t)128 * 2048 + (k0)); S##b3 = *(const uint4*)(Bp + (size_t)192 * 2048 + (k0)); }
#define G_STORE(S, nb) { bf16* a_ = As + (nb) * 128 * 72 + lr * 72 + lc; bf16* b_ = Bs + (nb) * 256 * 72 + lr * 72 + lc; \
    *(uint4*)a_ = S##a0; *(uint4*)(a_ + 64 * 72) = S##a1; *(uint4*)b_ = S##b0; *(uint4*)(b_ + 64 * 72) = S##b1; *(uint4*)(b_ + 128 * 72) = S##b2; *(uint4*)(b_ + 192 * 72) = S##b3; }
#define G_COMPUTE(buf) { const bf16* Ab = As + (buf) * 128 * 72 + (wm * 64 + l32) * 72 + hl * 8; const bf16* Bb = Bs + (buf) * 256 * 72 + (wn * 64 + l32) * 72 + hl * 8; \
    _Pragma("unroll") for (int kk = 0; kk < 4; ++kk) { \
      bf16x8 a0 = ld8(Ab + kk * 16), a1 = ld8(Ab + 32 * 72 + kk * 16); bf16x8 b0 = ld8(Bb + kk * 16), b1 = ld8(Bb + 32 * 72 + kk * 16); \
      acc[0][0] = mfma32(a0, b0, acc[0][0]); acc[0][1] = mfma32(a0, b1, acc[0][1]); acc[1][0] = mfma32(a1, b0, acc[1][0]); acc[1][1] = mfma32(a1, b1, acc[1][1]); } }
  __syncthreads();
  G_LOAD(s0, 0); G_LOAD(s1, 64); G_LOAD(s2, 128); G_LOAD(s3, 192);
  G_STORE(s0, 0);
  __syncthreads();
  for (int kt = 0; kt < 32; kt += 4) {
    if (kt + 4 < 32) G_LOAD(s0, (kt + 4) * 64);
    G_COMPUTE(0); G_STORE(s1, 1); __syncthreads();
    if (kt + 5 < 32) G_LOAD(s1, (kt + 5) * 64);
    G_COMPUTE(1); G_STORE(s2, 0); __syncthreads();
    if (kt + 6 < 32) G_LOAD(s2, (kt + 6) * 64);
    G_COMPUTE(0); G_STORE(s3, 1); __syncthreads();
    if (kt + 7 < 32) G_LOAD(s3, (kt + 7) * 64);
    G_COMPUTE(1); if (kt + 4 < 32) G_STORE(s0, 0); __syncthreads();
  }
  const int cb = n0 + wn * 64;
  const int rb0 = m0 + wm * 64;
  if constexpr (EPI != EPI_PEERQ) {
    epi64<EPI>(p, layer, cb, rb0, l32, hl, acc[0][0], acc[0][1], acc[1][0], acc[1][1]);
  } else {
    __builtin_amdgcn_sched_barrier(0);
    const int head = n0 >> 8;
    bf16* ql = (bf16*)smem;
    bf16* skl = ql + 128 * 264;
#pragma unroll
    for (int tm = 0; tm < 2; ++tm)
#pragma unroll
      for (int tn = 0; tn < 2; ++tn)
#pragma unroll
        for (int i = 0; i < 16; ++i) {
          int r = wm * 64 + tm * 32 + (i >> 2) * 8 + hl * 4 + (i & 3);
          ql[r * 264 + wn * 64 + tn * 32 + l32] = f2bf(acc[tm][tn][i]);
        }
    const bf16* sksrc = p.SK + (size_t)(layer * 8 + head) * 2 * 128 * 128;
#pragma unroll 2
    for (int i = 0; i < 8; ++i) {
      int q = tid + i * 512; int row = q >> 4, cc = (q & 15) * 8;
      *(uint4*)(skl + row * 136 + cc) = *(const uint4*)(sksrc + row * 128 + cc);
    }
    __syncthreads();
    for (int a = 0; a < 2; ++a) for (int b = 0; b < 2; ++b) acc[a][b] = zero16();
    const int pp = wn >> 1;
    const bf16* Ab = ql + (wm * 64 + l32) * 264 + pp * 128 + hl * 8;
    const bf16* Bb = skl + (wn * 64 + l32) * 136 + hl * 8;
#pragma unroll
    for (int kk = 0; kk < 8; ++kk) {
      bf16x8 a0 = ld8(Ab + kk * 16), a1 = ld8(Ab + 32 * 264 + kk * 16);
      bf16x8 b0 = ld8(Bb + kk * 16), b1 = ld8(Bb + 32 * 136 + kk * 16);
      acc[0][0] = mfma32(a0, b0, acc[0][0]);
      acc[0][1] = mfma32(a0, b1, acc[0][1]);
      acc[1][0] = mfma32(a1, b0, acc[1][0]);
      acc[1][1] = mfma32(a1, b1, acc[1][1]);
    }
    __syncthreads();
    uint32_t* sc = (uint32_t*)smem;
#pragma unroll
    for (int tm = 0; tm < 2; ++tm)
#pragma unroll
      for (int tn = 0; tn < 2; ++tn)
#pragma unroll
        for (int i = 0; i < 16; ++i) {
          int r = wm * 64 + tm * 32 + (i >> 2) * 8 + hl * 4 + (i & 3);
          const int col = wn * 64 + tn * 32 + l32;
          uint32_t u = __float_as_uint(acc[tm][tn][i]);
          u = (u & 0x80000000u) ? ~u : (u | 0x80000000u);
          sc[r * 260 + col] = (u & ~127u) | (uint32_t)(127 - (col & 127));
        }
    __syncthreads();
    const int sub = lane & 15;
    for (int rd = 0; rd < 8; ++rd) {
      int pr = rd * 32 + w * 4 + (lane >> 4);
      int tok = pr >> 1, ph = pr & 1;
      const uint32_t* src = sc + tok * 260 + ph * 128 + sub * 8;
      uint4 v0 = *(const uint4*)src, v1 = *(const uint4*)(src + 4);
      uint32_t v[8] = {v0.x, v0.y, v0.z, v0.w, v1.x, v1.y, v1.z, v1.w};
      uint32_t mykey = 0;
      for (int it = 0; it < 16; ++it) {
        uint32_t m = max(max(max(v[0], v[1]), max(v[2], v[3])), max(max(v[4], v[5]), max(v[6], v[7])));
        m = max(m, (uint32_t)__builtin_amdgcn_update_dpp(0, (int)m, 0x128, 0xF, 0xF, false));
        m = max(m, (uint32_t)__builtin_amdgcn_update_dpp(0, (int)m, 0x124, 0xF, 0xF, false));
        m = max(m, (uint32_t)__builtin_amdgcn_update_dpp(0, (int)m, 0x122, 0xF, 0xF, false));
        m = max(m, (uint32_t)__builtin_amdgcn_update_dpp(0, (int)m, 0x121, 0xF, 0xF, false));
        if (sub == it) mykey = m;
#pragma unroll
        for (int j = 0; j < 8; ++j) v[j] = (v[j] == m) ? 0u : v[j];
      }
      uint32_t vb = mykey & ~127u;
      vb = (vb & 0x80000000u) ? (vb & 0x7fffffffu) : ~vb;
      size_t o = ((size_t)(m0 + tok) * 8 + head) * 32 + ph * 16 + sub;
      p.sv[o] = __uint_as_float(vb); p.si[o] = 127 - (int)(mykey & 127u);
    }
  }
}

template <int EPI>
DEV void phase_gemm(const Params& p, const bf16* A, const bf16* Bt, int mtiles, int ntiles, int layer, char* smem, int base, int total) {
  for (int it = blockIdx.x; it < total; it += gridDim.x) {
    int t = it - base;
    if (t < 0 || t >= mtiles * ntiles) continue;
    int mt = t % mtiles, nt = t / mtiles;
    gemm_tile<EPI>(p, A, Bt, mt * 128, nt * 256, layer, smem);
  }
}

template <int EPI>
DEV void gemm_tile2(const Params& p, const bf16* __restrict__ A, const bf16* __restrict__ Bt, int m0, int n0, int layer, char* smem) {
  bf16* As = (bf16*)smem;
  bf16* Bs = As + 2 * 256 * 72;
  const int tid = threadIdx.x, lane = tid & 63, w = tid >> 6, wm = w >> 1, wn = w & 1, l32 = lane & 31, hl = lane >> 5;
  f32x16 acc[2][4];
#pragma unroll
  for (int a = 0; a < 2; ++a)
#pragma unroll
    for (int b = 0; b < 4; ++b) acc[a][b] = zero16();
  uint4 t0a0, t0a1, t0a2, t0a3, t0b0, t0b1, t0b2, t0b3;
  const int lr = tid >> 3, lc = (tid & 7) * 8;
  const bf16* Ap = A + (size_t)(m0 + lr) * 2048 + lc;
  const bf16* Bp = Bt + (size_t)(n0 + lr) * 2048 + lc;
#define H_LOAD(S, KOFF) { S##a0 = *(const uint4*)(Ap + (KOFF)); S##a1 = *(const uint4*)(Ap + (size_t)64 * 2048 + (KOFF)); S##a2 = *(const uint4*)(Ap + (size_t)128 * 2048 + (KOFF)); S##a3 = *(const uint4*)(Ap + (size_t)192 * 2048 + (KOFF)); \
    S##b0 = *(const uint4*)(Bp + (KOFF)); S##b1 = *(const uint4*)(Bp + (size_t)64 * 2048 + (KOFF)); S##b2 = *(const uint4*)(Bp + (size_t)128 * 2048 + (KOFF)); S##b3 = *(const uint4*)(Bp + (size_t)192 * 2048 + (KOFF)); }
#define H_STORE(S, nb) { bf16* a_ = As + (nb) * 256 * 72 + lr * 72 + lc; bf16* b_ = Bs + (nb) * 256 * 72 + lr * 72 + lc; \
    *(uint4*)a_ = S##a0; *(uint4*)(a_ + 64 * 72) = S##a1; *(uint4*)(a_ + 128 * 72) = S##a2; *(uint4*)(a_ + 192 * 72) = S##a3; \
    *(uint4*)b_ = S##b0; *(uint4*)(b_ + 64 * 72) = S##b1; *(uint4*)(b_ + 128 * 72) = S##b2; *(uint4*)(b_ + 192 * 72) = S##b3; }
#define H_FRAGS(F, Ab, Bb, kk) { F##a0 = ld8(Ab + (kk) * 16); F##a1 = ld8(Ab + 32 * 72 + (kk) * 16); \
    F##b0 = ld8(Bb + (kk) * 16); F##b1 = ld8(Bb + 32 * 72 + (kk) * 16); F##b2 = ld8(Bb + 64 * 72 + (kk) * 16); F##b3 = ld8(Bb + 96 * 72 + (kk) * 16); }
#define H_MFMA8(F) { acc[0][0] = mfma32(F##a0, F##b0, acc[0][0]); acc[0][1] = mfma32(F##a0, F##b1, acc[0][1]); acc[0][2] = mfma32(F##a0, F##b2, acc[0][2]); acc[0][3] = mfma32(F##a0, F##b3, acc[0][3]); \
    acc[1][0] = mfma32(F##a1, F##b0, acc[1][0]); acc[1][1] = mfma32(F##a1, F##b1, acc[1][1]); acc[1][2] = mfma32(F##a1, F##b2, acc[1][2]); acc[1][3] = mfma32(F##a1, F##b3, acc[1][3]); }
#define H_SCHED_RM() {}
#define H_COMPUTE(buf) { const bf16* Ab = As + (buf) * 256 * 72 + (wm * 64 + l32) * 72 + hl * 8; const bf16* Bb = Bs + (buf) * 256 * 72 + (wn * 128 + l32) * 72 + hl * 8; \
    bf16x8 fa0, fa1, fb0, fb1, fb2, fb3, ga0, ga1, gb0, gb1, gb2, gb3; \
    H_FRAGS(f, Ab, Bb, 0); \
    H_FRAGS(g, Ab, Bb, 1); H_MFMA8(f); H_SCHED_RM(); \
    H_FRAGS(f, Ab, Bb, 2); H_MFMA8(g); H_SCHED_RM(); \
    H_FRAGS(g, Ab, Bb, 3); H_MFMA8(f); H_SCHED_RM(); \
    H_MFMA8(g); }
  __syncthreads();
  H_LOAD(t0, 0);
  H_STORE(t0, 0);
  H_LOAD(t0, 64);
  __syncthreads();
  for (int kt = 0; kt < 32; kt += 2) {
    H_STORE(t0, 1);
    if (kt + 2 < 32) H_LOAD(t0, (kt + 2) * 64);
    H_COMPUTE(0); __syncthreads();
    if (kt + 2 < 32) H_STORE(t0, 0);
    if (kt + 3 < 32) H_LOAD(t0, (kt + 3) * 64);
    H_COMPUTE(1); __syncthreads();
  }
  const int rb0 = m0 + wm * 64;
  epi64<EPI>(p, layer, n0 + wn * 128, rb0, l32, hl, acc[0][0], acc[0][1], acc[1][0], acc[1][1]);
  epi64<EPI>(p, layer, n0 + wn * 128 + 64, rb0, l32, hl, acc[0][2], acc[0][3], acc[1][2], acc[1][3]);
}

template <int EPI>
DEV void phase_gemm2(const Params& p, const bf16* A, const bf16* Bt, int mtiles, int ntiles, int layer, char* smem, int base, int total) {
  for (int it = blockIdx.x; it < total; it += gridDim.x) {
    int t = it - base;
    if (t < 0 || t >= mtiles * ntiles) continue;
    int mt = t % mtiles, nt = t / mtiles;
    gemm_tile2<EPI>(p, A, Bt, mt * 256, nt * 256, layer, smem);
  }
}

DEV void phase_ln(const Params& p, const float* g, const float* bta, const float* hin) {
  const int lane = threadIdx.x & 63, w = threadIdx.x >> 6;
  for (int t = blockIdx.x * 8 + w; t < T_; t += gridDim.x * 8) {
    float* row = p.hf + (size_t)t * 2048;
    const float* hrow = hin + (size_t)t * 2048;
    const bf16* yrow = p.ybf + (size_t)t * 2048;
    float4 v[8]; float s = 0.f;
#pragma unroll
    for (int c = 0; c < 8; ++c) {
      const float4 hh = *(const float4*)(hrow + c * 256 + lane * 4); const uint2 yy = *(const uint2*)(yrow + c * 256 + lane * 4);
      v[c].x = DN_ALPHA * hh.x + bflo(yy.x); v[c].y = DN_ALPHA * hh.y + bfhi(yy.x); v[c].z = DN_ALPHA * hh.z + bflo(yy.y); v[c].w = DN_ALPHA * hh.w + bfhi(yy.y);
      s += v[c].x + v[c].y + v[c].z + v[c].w;
    }
    float mu = wave_sum(s) * (1.f / 2048.f);
    float q = 0.f;
#pragma unroll
    for (int c = 0; c < 8; ++c) { float a = v[c].x - mu, b = v[c].y - mu, cc = v[c].z - mu, d = v[c].w - mu; q += a * a + b * b + cc * cc + d * d; }
    float rstd = rsqrtf(wave_sum(q) * (1.f / 2048.f) + LN_EPS);
#pragma unroll
    for (int c = 0; c < 8; ++c) {
      int o = c * 256 + lane * 4;
      float4 gg = *(const float4*)(g + o), bb = *(const float4*)(bta + o), r;
      r.x = (v[c].x - mu) * rstd * gg.x + bb.x; r.y = (v[c].y - mu) * rstd * gg.y + bb.y;
      r.z = (v[c].z - mu) * rstd * gg.z + bb.z; r.w = (v[c].w - mu) * rstd * gg.w + bb.w;
      *(float4*)(row + o) = r;
      uint2 h; h.x = pack2(r.x, r.y); h.y = pack2(r.z, r.w);
      *(uint2*)(p.hbf + (size_t)t * 2048 + o) = h;
    }
  }
}

template <int DQ, int NMAP>
DEV void attn_core(const bf16* __restrict__ Qp, int ldq, const bf16* __restrict__ Kp, int ldk,
                   const bf16* __restrict__ Vtp, int ldvt, int nkeys, char* smem, f32x16 (&o)[4], float& ltot) {
  bf16* Ks = (bf16*)smem;
  bf16* Vs = Ks + 2 * 64 * 136;
  const int tid = threadIdx.x, lane = tid & 63, w = tid >> 6, l32 = lane & 31, hl = lane >> 5;
  const int qg = NMAP == 2 ? (w & 3) : w, mp = NMAP == 2 ? (w >> 2) : 0;
  bf16x8 qf[DQ / 16];
#pragma unroll
  for (int kk = 0; kk < DQ / 16; ++kk) qf[kk] = ld8(Qp + (size_t)(qg * 32 + l32) * ldq + mp * DQ + kk * 16 + hl * 8);
#pragma unroll
  for (int d = 0; d < 4; ++d) o[d] = zero16();
  float m_run = -1e30f, l_run = 0.f;
  uint4 rk0, rk1, rv0, rv1;
  const int kr = tid >> 4, kc = (tid & 15) * 8;
  const int vr = tid >> 3, vc = (tid & 7) * 8;
  const bf16* Kg = Kp + (size_t)kr * ldk + kc;
  const bf16* Vg = Vtp + (size_t)vr * ldvt + vc;
  __syncthreads();
  rk0 = *(const uint4*)(Kg); rk1 = *(const uint4*)(Kg + (size_t)32 * ldk);
  rv0 = *(const uint4*)(Vg); rv1 = *(const uint4*)(Vg + (size_t)64 * ldvt);
  *(uint4*)(Ks + kr * 136 + kc) = rk0; *(uint4*)(Ks + (kr + 32) * 136 + kc) = rk1;
  *(uint4*)(Vs + vr * 72 + vc) = rv0; *(uint4*)(Vs + (vr + 64) * 72 + vc) = rv1;
  __syncthreads();
  const int ntile = nkeys >> 6;
  for (int kt = 0; kt < ntile; ++kt) {
    const int buf = kt & 1;
    if (kt + 1 < ntile) {
      const int k0 = (kt + 1) * 64;
      rk0 = *(const uint4*)(Kg + (size_t)k0 * ldk); rk1 = *(const uint4*)(Kg + (size_t)(k0 + 32) * ldk);
      rv0 = *(const uint4*)(Vg + k0); rv1 = *(const uint4*)(Vg + (size_t)64 * ldvt + k0);
    }
    const bf16* Kb = Ks + buf * 64 * 136 + l32 * 136 + mp * DQ + hl * 8;
    const bf16* Vb = Vs + buf * 128 * 72 + l32 * 72 + hl * 4;
    f32x16 s[2];
#pragma unroll
    for (int st = 0; st < 2; ++st) {
      s[st] = zero16();
#pragma unroll
      for (int kk = 0; kk < DQ / 16; ++kk) s[st] = mfma32(ld8(Kb + st * 32 * 136 + kk * 16), qf[kk], s[st]);
    }
    float mx = s[0][0];
#pragma unroll
    for (int i = 0; i < 16; ++i) { mx = fmaxf(mx, s[0][i]); mx = fmaxf(mx, s[1][i]); }
    mx = fmaxf(mx, __shfl_xor(mx, 32));
    float mnew = fmaxf(m_run, mx);
    float alpha = __builtin_amdgcn_exp2f(m_run - mnew); m_run = mnew;
    float rs = 0.f;
#pragma unroll
    for (int i = 0; i < 16; ++i) { s[0][i] = __builtin_amdgcn_exp2f(s[0][i] - mnew); s[1][i] = __builtin_amdgcn_exp2f(s[1][i] - mnew); rs += s[0][i] + s[1][i]; }
    l_run = l_run * alpha + rs;
    if (__builtin_amdgcn_ballot_w64(alpha != 1.f) != 0) {
#pragma unroll
      for (int d = 0; d < 4; ++d)
#pragma unroll
        for (int i = 0; i < 16; ++i) o[d][i] *= alpha;
    }
#pragma unroll
    for (int st = 0; st < 2; ++st)
#pragma unroll
      for (int hs = 0; hs < 2; ++hs) {
        bf16x8 pb = mk8(pack2(s[st][hs * 8 + 0], s[st][hs * 8 + 1]), pack2(s[st][hs * 8 + 2], s[st][hs * 8 + 3]),
                        pack2(s[st][hs * 8 + 4], s[st][hs * 8 + 5]), pack2(s[st][hs * 8 + 6], s[st][hs * 8 + 7]));
#pragma unroll
        for (int d = 0; d < 4; ++d) {
          const bf16* vp = Vb + d * 32 * 72 + st * 32 + hs * 16;
          uint2 x0 = *(const uint2*)vp, x1 = *(const uint2*)(vp + 8);
          o[d] = mfma32(mk8(x0.x, x0.y, x1.x, x1.y), pb, o[d]);
        }
      }
    if (kt + 1 < ntile) {
      const int nb = buf ^ 1;
      *(uint4*)(Ks + nb * 64 * 136 + kr * 136 + kc) = rk0; *(uint4*)(Ks + nb * 64 * 136 + (kr + 32) * 136 + kc) = rk1;
      *(uint4*)(Vs + nb * 128 * 72 + vr * 72 + vc) = rv0; *(uint4*)(Vs + nb * 128 * 72 + (vr + 64) * 72 + vc) = rv1;
    }
    __syncthreads();
  }
  ltot = l_run + __shfl_xor(l_run, 32);
}

DEV void mem_attn_item(const Params& p, int it, int qmcol, char* smem) {
  const int b = it >> 5, mh = (it >> 3) & 3, qb = it & 7;
  const int lane = threadIdx.x & 63, w = threadIdx.x >> 6, l32 = lane & 31, hl = lane >> 5;
  f32x16 o[4]; float lt;
  const size_t t0 = (size_t)b * 2048 + qb * 256;
  attn_core<128, 1>(p.proj + t0 * PLD + qmcol + mh * 128, PLD, p.memK + (size_t)b * 256 * 512 + mh * 128, 512,
                    p.memVt + (size_t)(b * 4 + mh) * 128 * 256, 256, 256, smem, o, lt);
  const float inv = 1.f / lt;
  bf16* dst = p.hbf + (t0 + w * 32 + l32) * 2048 + 1536 + mh * 128;
#pragma unroll
  for (int d = 0; d < 4; ++d)
#pragma unroll
    for (int g = 0; g < 4; ++g) {
      uint2 v; v.x = pack2(o[d][g * 4] * inv, o[d][g * 4 + 1] * inv); v.y = pack2(o[d][g * 4 + 2] * inv, o[d][g * 4 + 3] * inv);
      *(uint2*)(dst + d * 32 + g * 8 + hl * 4) = v;
    }
}

DEV void diff_attn_item(const Params& p, int it, float lam, char* smem) {
  const int qb = it & 15, hh = (it >> 4) % 12, b = it / 192;
  const int lane = threadIdx.x & 63, w = threadIdx.x >> 6, l32 = lane & 31, hl = lane >> 5;
  const int qg = w & 3, mp = w >> 2;
  f32x16 o[4]; float lt;
  const size_t t0 = (size_t)b * 2048 + qb * 128;
  attn_core<64, 2>(p.proj + t0 * PLD + hh * 128, PLD, p.proj + (size_t)b * 2048 * PLD + 1536 + hh * 128, PLD,
                   p.Vt + (size_t)(b * 12 + hh) * 128 * 2048, 2048, 2048, smem, o, lt);
  const float inv = 1.f / lt;
  float* ob = (float*)smem;
  if (mp == 1) {
#pragma unroll
    for (int d = 0; d < 4; ++d)
#pragma unroll
      for (int g = 0; g < 4; ++g) {
        float4 v; v.x = o[d][g * 4] * inv; v.y = o[d][g * 4 + 1] * inv; v.z = o[d][g * 4 + 2] * inv; v.w = o[d][g * 4 + 3] * inv;
        *(float4*)(ob + (qg * 32 + l32) * 132 + d * 32 + g * 8 + hl * 4) = v;
      }
  }
  __syncthreads();
  if (mp == 0) {
    float ss = 0.f;
#pragma unroll
    for (int d = 0; d < 4; ++d)
#pragma unroll
      for (int g = 0; g < 4; ++g) {
        float4 v = *(const float4*)(ob + (qg * 32 + l32) * 132 + d * 32 + g * 8 + hl * 4);
        o[d][g * 4] = o[d][g * 4] * inv - lam * v.x; o[d][g * 4 + 1] = o[d][g * 4 + 1] * inv - lam * v.y;
        o[d][g * 4 + 2] = o[d][g * 4 + 2] * inv - lam * v.z; o[d][g * 4 + 3] = o[d][g * 4 + 3] * inv - lam * v.w;
        ss += o[d][g * 4] * o[d][g * 4] + o[d][g * 4 + 1] * o[d][g * 4 + 1] + o[d][g * 4 + 2] * o[d][g * 4 + 2] + o[d][g * 4 + 3] * o[d][g * 4 + 3];
      }
    ss += __shfl_xor(ss, 32);
    const float rn = rsqrtf(ss * (1.f / 128.f) + LN_EPS) * 0.8f;
    const float* gn = p.attn_hn + hh * 128;
    bf16* dst = p.hbf + (t0 + qg * 32 + l32) * 2048 + hh * 128;
#pragma unroll
    for (int d = 0; d < 4; ++d)
#pragma unroll
      for (int g = 0; g < 4; ++g) {
        int c = d * 32 + g * 8 + hl * 4;
        float4 gg = *(const float4*)(gn + c);
        uint2 v; v.x = pack2(o[d][g * 4] * rn * gg.x, o[d][g * 4 + 1] * rn * gg.y); v.y = pack2(o[d][g * 4 + 2] * rn * gg.z, o[d][g * 4 + 3] * rn * gg.w);
        *(uint2*)(dst + c) = v;
      }
  }
  __syncthreads();
}

DEV void phase_attn0(const Params& p, char* smem) {
  float a = 0.f, c = 0.f;
  for (int i = 0; i < 64; ++i) { a += p.attn_lam[i] * p.attn_lam[64 + i]; c += p.attn_lam[128 + i] * p.attn_lam[192 + i]; }
  const float lam = expf(a) - expf(c) + 0.2f;
  for (int it = blockIdx.x; it < 1536 + 256; it += gridDim.x) {
    if (it < 1536) diff_attn_item(p, it, lam, smem);
    else mem_attn_item(p, it - 1536, 3072, smem);
  }
}

DEV float log_sigmoid(float x) { return fminf(x, 0.f) - log1pf(expf(-fabsf(x))); }

DEV void gate_vectors(const Params& p, int b, int hh, int dir, int c, int lane, float& R0, float& R1, float& C0, float& C1, float& total) {
  const size_t t = (size_t)b * 2048 + c * 128 + lane * 2;
  const int ci = (2 * dir) * 12 + hh, cf = (2 * dir + 1) * 12 + hh;
  float i0 = p.gates[t * 48 + ci] + p.ml_gb[ci], i1 = p.gates[(t + 1) * 48 + ci] + p.ml_gb[ci];
  float f0 = log_sigmoid(p.gates[t * 48 + cf] + p.ml_gb[cf]), f1 = log_sigmoid(p.gates[(t + 1) * 48 + cf] + p.ml_gb[cf]);
  float s = f0 + f1;
  for (int o = 1; o < 64; o <<= 1) { float u = __shfl_up(s, o); if (lane >= o) s += u; }
  total = __shfl(s, 63);
  float p1 = s, p0 = s - f1;
  if (dir == 0) { R0 = p0; R1 = p1; }
  else { R0 = total - (p0 - f0); R1 = total - (p1 - f1); }
  C0 = i0 - R0; C1 = i1 - R1;
}

DEV void ml_summary_item(const Params& p, int it, char* smem) {
  const int c = it & 15, dir = (it >> 4) & 1, bh = it >> 5, hh = bh % 12, b = bh / 12;
  bf16* kwT = (bf16*)smem;
  bf16* vT = kwT + 128 * 136;
  float* wa = (float*)(vT + 128 * 136);
  const int tid = threadIdx.x, lane = tid & 63, w = tid >> 6, l32 = lane & 31, hl = lane >> 5;
  __syncthreads();
  if (w == 0) {
    float R0, R1, C0, C1, tot; gate_vectors(p, b, hh, dir, c, lane, R0, R1, C0, C1, tot);
    float a0 = tot + C0, a1 = tot + C1;
    float am = wave_max(fmaxf(a0, a1));
    wa[lane * 2] = expf(a0 - am); wa[lane * 2 + 1] = expf(a1 - am);
    if (lane == 0) { p.scal[it * 2] = tot; p.scal[it * 2 + 1] = am; }
  }
  const size_t t0 = (size_t)b * 2048 + c * 128;
  const bf16* vsrc = p.Vt + (size_t)(b * 12 + hh) * 128 * 2048 + c * 128;
#pragma unroll
  for (int i = 0; i < 4; ++i) { int q = tid + i * 512; int r = q >> 4, cc = (q & 15) * 8; *(uint4*)(vT + r * 136 + cc) = *(const uint4*)(vsrc + (size_t)r * 2048 + cc); }
  __syncthreads();
  const bf16* ksrc = p.proj + t0 * PLD + 1536 + hh * 128;
#pragma unroll
  for (int i = 0; i < 4; ++i) {
    int q = tid + i * 512; int s = q & 127, kc = (q >> 7) * 8;
    uint4 kv = *(const uint4*)(ksrc + (size_t)s * PLD + kc);
    float wgt = wa[s];
    uint32_t u[4] = {kv.x, kv.y, kv.z, kv.w};
#pragma unroll
    for (int j = 0; j < 4; ++j) { kwT[(kc + 2 * j) * 136 + s] = f2bf(bflo(u[j]) * wgt); kwT[(kc + 2 * j + 1) * 136 + s] = f2bf(bfhi(u[j]) * wgt); }
  }
  __syncthreads();
  const int mt = w >> 1, ntb = (w & 1) * 2;
  f32x16 acc[2] = {zero16(), zero16()};
#pragma unroll
  for (int kk = 0; kk < 8; ++kk) {
    bf16x8 a = ld8(vT + (mt * 32 + l32) * 136 + kk * 16 + hl * 8);
#pragma unroll
    for (int n = 0; n < 2; ++n) acc[n] = mfma32(a, ld8(kwT + ((ntb + n) * 32 + l32) * 136 + kk * 16 + hl * 8), acc[n]);
  }
  bf16* dst = p.kvT + (size_t)it * 16384;
#pragma unroll
  for (int n = 0; n < 2; ++n)
#pragma unroll
    for (int i = 0; i < 16; ++i) dst[(mt * 32 + (i >> 2) * 8 + hl * 4 + (i & 3)) * 128 + (ntb + n) * 32 + l32] = f2bf(acc[n][i]);
  if (tid < 128) {
    float s = 0.f;
    for (int j = 0; j < 128; ++j) s += bf2f(kwT[tid * 136 + j]);
    p.nvec[(size_t)it * 128 + tid] = s;
  }
}

DEV void ml_scan_item(const Params& p, int it) {
  const int slab = it & 3, bhd = it >> 2, dir = bhd & 1, tid = threadIdx.x;
  float C[8];
#pragma unroll
  for (int j = 0; j < 8; ++j) C[j] = 0.f;
  float4 Nn = make_float4(0.f, 0.f, 0.f, 0.f);
  float m = 0.f;
  const bool doN = (slab == 0 && tid < 32);
  const size_t eoff = (size_t)slab * 4096 + tid * 8;
  uint4 cur = *(const uint4*)(p.kvT + (size_t)(bhd * 16 + (dir ? 15 : 0)) * 16384 + eoff);
  for (int cc = 0; cc < 16; ++cc) {
    const int c = dir ? 15 - cc : cc;
    const int id9 = bhd * 16 + c;
    uint4 nxt = make_uint4(0u, 0u, 0u, 0u);
    if (cc + 1 < 16) nxt = *(const uint4*)(p.kvT + (size_t)(bhd * 16 + (dir ? 14 - cc : cc + 1)) * 16384 + eoff);
    const float bl = p.scal[id9 * 2], am = p.scal[id9 * 2 + 1];
    uint4 st; st.x = pack2(C[0], C[1]); st.y = pack2(C[2], C[3]); st.z = pack2(C[4], C[5]); st.w = pack2(C[6], C[7]);
    *(uint4*)(p.kvT + (size_t)id9 * 16384 + eoff) = st;
    float4 nn = make_float4(0.f, 0.f, 0.f, 0.f);
    if (doN) { float4* pn = (float4*)(p.nvec + (size_t)id9 * 128 + tid * 4); nn = *pn; *pn = Nn; }
    if (slab == 0 && tid == 0) p.mst[id9] = m;
    const float mn = fmaxf(bl + m, am);
    const float dec = expf(bl + m - mn), ww = expf(am - mn);
    const float kv[8] = {bflo(cur.x), bfhi(cur.x), bflo(cur.y), bfhi(cur.y), bflo(cur.z), bfhi(cur.z), bflo(cur.w), bfhi(cur.w)};
#pragma unroll
    for (int j = 0; j < 8; ++j) C[j] = dec * C[j] + ww * kv[j];
    Nn.x = dec * Nn.x + ww * nn.x; Nn.y = dec * Nn.y + ww * nn.y; Nn.z = dec * Nn.z + ww * nn.z; Nn.w = dec * Nn.w + ww * nn.w;
    m = mn; cur = nxt;
  }
}

DEV void ml_out_item(const Params& p, int it, char* smem) {
  const int c = it & 15, bh = it >> 4, hh = bh % 12, b = bh / 12;
  bf16* ks = (bf16*)smem;
  bf16* vT = ks + 128 * 136;
  bf16* CT = vT + 128 * 136;
  float* vec = (float*)(CT + 2 * 128 * 136);
  float *Rv = vec, *Cv = vec + 256, *Mv = vec + 512, *nS = vec + 768, *msv = vec + 1024;
  const int tid = threadIdx.x, lane = tid & 63, w = tid >> 6, l32 = lane & 31, hl = lane >> 5;
  const int dir = w >> 2, qg = w & 3;
  const size_t t0 = (size_t)b * 2048 + c * 128;
  __syncthreads();
  if (w < 2) {
    const int dr = w;
    const int id9 = (bh * 2 + dr) * 16 + c;
    float R0, R1, C0, C1, tot; gate_vectors(p, b, hh, dr, c, lane, R0, R1, C0, C1, tot);
    const float ms = p.mst[id9];
    float mx = fmaxf(C0, C1), x0, x1;
    if (dr == 0) {
      for (int o = 1; o < 64; o <<= 1) { float u = __shfl_up(mx, o); if (lane >= o) mx = fmaxf(mx, u); }
      float prev = __shfl_up(mx, 1); if (lane == 0) prev = -3.0e38f;
      x0 = fmaxf(prev, C0); x1 = mx;
    } else {
      for (int o = 1; o < 64; o <<= 1) { float u = __shfl_down(mx, o); if (lane + o < 64) mx = fmaxf(mx, u); }
      float nxt = __shfl_down(mx, 1); if (lane == 63) nxt = -3.0e38f;
      x1 = fmaxf(nxt, C1); x0 = mx;
    }
    Rv[dr * 128 + lane * 2] = R0; Rv[dr * 128 + lane * 2 + 1] = R1;
    Cv[dr * 128 + lane * 2] = C0; Cv[dr * 128 + lane * 2 + 1] = C1;
    Mv[dr * 128 + lane * 2] = fmaxf(R0 + ms, R0 + x0); Mv[dr * 128 + lane * 2 + 1] = fmaxf(R1 + ms, R1 + x1);
    nS[dr * 128 + lane * 2] = p.nvec[(size_t)id9 * 128 + lane * 2]; nS[dr * 128 + lane * 2 + 1] = p.nvec[(size_t)id9 * 128 + lane * 2 + 1];
    if (lane == 0) msv[dr] = ms;
  }
  {
    const bf16* ksrc = p.proj + t0 * PLD + 1536 + hh * 128;
    const bf16* vsrc = p.Vt + (size_t)(b * 12 + hh) * 128 * 2048 + c * 128;
#pragma unroll
    for (int i = 0; i < 4; ++i) {
      int q = tid + i * 512; int r = q >> 4, cc = (q & 15) * 8;
      *(uint4*)(ks + r * 136 + cc) = *(const uint4*)(ksrc + (size_t)r * PLD + cc);
      *(uint4*)(vT + r * 136 + cc) = *(const uint4*)(vsrc + (size_t)r * 2048 + cc);
    }
#pragma unroll 1
    for (int dr = 0; dr < 2; ++dr) {
      const bf16* csrc = p.kvT + (size_t)((bh * 2 + dr) * 16 + c) * 16384;
#pragma unroll
      for (int i = 0; i < 4; ++i) {
        int q = tid + i * 512; int r = q >> 4, cc = (q & 15) * 8;
        *(uint4*)(CT + dr * 128 * 136 + r * 136 + cc) = *(const uint4*)(csrc + r * 128 + cc);
      }
    }
  }
  __syncthreads();
  const int j = qg * 32 + l32;
  bf16x8 qf[8];
#pragma unroll
  for (int kk = 0; kk < 8; ++kk) qf[kk] = ld8(p.proj + (t0 + j) * PLD + hh * 128 + kk * 16 + hl * 8);
  f32x16 acc[4];
#pragma unroll
  for (int d = 0; d < 4; ++d) acc[d] = zero16();
  const bf16* Cb = CT + dir * 128 * 136 + l32 * 136 + hl * 8;
#pragma unroll
  for (int d = 0; d < 4; ++d) {
#pragma unroll
    for (int kk = 0; kk < 8; ++kk) acc[d] = mfma32(ld8(Cb + d * 32 * 136 + kk * 16), qf[kk], acc[d]);
    __builtin_amdgcn_sched_barrier(0);
  }
  float qn = 0.f;
#pragma unroll
  for (int kk = 0; kk < 8; ++kk)
#pragma unroll
    for (int e = 0; e < 8; ++e) qn += bf2f((bf16)qf[kk][e]) * nS[dir * 128 + kk * 16 + hl * 8 + e];
  qn += __shfl_xor(qn, 32);
  const float Rj = Rv[dir * 128 + j], Mj = Mv[dir * 128 + j], ms = msv[dir];
  const float wi = __expf(Rj + ms - Mj);
#pragma unroll
  for (int d = 0; d < 4; ++d)
#pragma unroll
    for (int i = 0; i < 16; ++i) acc[d][i] *= wi;
  float den = 0.f;
  const float rowt = Rj - Mj;
#pragma unroll 1
  for (int st = 0; st < 4; ++st) {
    if (dir == 0 ? (st > qg) : (st < qg)) continue;
    f32x16 s = zero16();
#pragma unroll
    for (int kk = 0; kk < 8; ++kk) s = mfma32(ld8(ks + (st * 32 + l32) * 136 + kk * 16 + hl * 8), qf[kk], s);
    __builtin_amdgcn_sched_barrier(0);
#pragma unroll
    for (int i = 0; i < 16; ++i) {
      int sidx = st * 32 + (i >> 2) * 8 + hl * 4 + (i & 3);
      bool ok = dir == 0 ? (sidx <= j) : (sidx >= j);
      float wgt = ok ? __expf(rowt + Cv[dir * 128 + sidx]) : 0.f;
      s[i] *= wgt; den += s[i];
    }
#pragma unroll
    for (int hs = 0; hs < 2; ++hs) {
      bf16x8 pb = mk8(pack2(s[hs * 8 + 0], s[hs * 8 + 1]), pack2(s[hs * 8 + 2], s[hs * 8 + 3]), pack2(s[hs * 8 + 4], s[hs * 8 + 5]), pack2(s[hs * 8 + 6], s[hs * 8 + 7]));
#pragma unroll
      for (int d = 0; d < 4; ++d) {
        const bf16* vp = vT + (d * 32 + l32) * 136 + st * 32 + hs * 16 + hl * 4;
        uint2 x0 = *(const uint2*)vp, x1 = *(const uint2*)(vp + 8);
        acc[d] = mfma32(mk8(x0.x, x0.y, x1.x, x1.y), pb, acc[d]);
      }
      __builtin_amdgcn_sched_barrier(0);
    }
  }
  den += __shfl_xor(den, 32);
  den += wi * qn;
  const float rd = 1.f / fmaxf(fabsf(den), __expf(-Mj));
  __syncthreads();
  float* hb = (float*)CT;
#ifdef DBG
  {
    float* hx = dir == 1 ? hb : (float*)smem;
#pragma unroll
    for (int d = 0; d < 4; ++d)
#pragma unroll
      for (int g = 0; g < 4; ++g) {
        float4 v; v.x = acc[d][g * 4] * rd; v.y = acc[d][g * 4 + 1] * rd; v.z = acc[d][g * 4 + 2] * rd; v.w = acc[d][g * 4 + 3] * rd;
        *(float4*)(hx + j * 132 + d * 32 + g * 8 + hl * 4) = v;
      }
  }
  __syncthreads();
  for (int k = 0; k < 8; ++k) {
    if (it == (((2 + k) % 8) * 12 + (5 + 5 * k) % 12) * 16 + (2 + 3 * k) % 16) {
      float* dd = p.mst + 4096 + k * 32768;
      for (int e = tid; e < 16384; e += 512) { dd[e] = ((float*)smem)[(e >> 7) * 132 + (e & 127)]; dd[16384 + e] = hb[(e >> 7) * 132 + (e & 127)]; }
    }
  }
#else
  if (dir == 1) {
#pragma unroll
    for (int d = 0; d < 4; ++d)
#pragma unroll
      for (int g = 0; g < 4; ++g) {
        float4 v; v.x = acc[d][g * 4] * rd; v.y = acc[d][g * 4 + 1] * rd; v.z = acc[d][g * 4 + 2] * rd; v.w = acc[d][g * 4 + 3] * rd;
        *(float4*)(hb + j * 132 + d * 32 + g * 8 + hl * 4) = v;
      }
  }
  __syncthreads();
#endif
  if (dir == 0) {
    float ss = 0.f;
#pragma unroll
    for (int d = 0; d < 4; ++d)
#pragma unroll
      for (int g = 0; g < 4; ++g) {
        float4 v = *(const float4*)(hb + j * 132 + d * 32 + g * 8 + hl * 4);
        acc[d][g * 4] = acc[d][g * 4] * rd + v.x; acc[d][g * 4 + 1] = acc[d][g * 4 + 1] * rd + v.y;
        acc[d][g * 4 + 2] = acc[d][g * 4 + 2] * rd + v.z; acc[d][g * 4 + 3] = acc[d][g * 4 + 3] * rd + v.w;
        ss += acc[d][g * 4] * acc[d][g * 4] + acc[d][g * 4 + 1] * acc[d][g * 4 + 1] + acc[d][g * 4 + 2] * acc[d][g * 4 + 2] + acc[d][g * 4 + 3] * acc[d][g * 4 + 3];
      }
    ss += __shfl_xor(ss, 32);
    const float rn = rsqrtf(ss * (1.f / 128.f) + LN_EPS);
    const float* gn = p.ml_hn + hh * 128;
    const bf16* osrc = p.proj + (t0 + j) * PLD + 3072 + hh * 128;
    bf16* dst = p.hbf + (t0 + j) * 2048 + hh * 128;
#pragma unroll
    for (int d = 0; d < 4; ++d)
#pragma unroll
      for (int g = 0; g < 4; ++g) {
        int cc = d * 32 + g * 8 + hl * 4;
        float4 gg = *(const float4*)(gn + cc);
        uint2 ov = *(const uint2*)(osrc + cc);
        float o0 = 1.f / (1.f + __expf(-bflo(ov.x))), o1 = 1.f / (1.f + __expf(-bfhi(ov.x))), o2 = 1.f / (1.f + __expf(-bflo(ov.y))), o3 = 1.f / (1.f + __expf(-bfhi(ov.y)));
        uint2 v; v.x = pack2(acc[d][g * 4] * rn * gg.x * o0, acc[d][g * 4 + 1] * rn * gg.y * o1);
        v.y = pack2(acc[d][g * 4 + 2] * rn * gg.z * o2, acc[d][g * 4 + 3] * rn * gg.w * o3);
        *(uint2*)(dst + cc) = v;
      }
  }
  __syncthreads();
}

typedef __attribute__((ext_vector_type(2))) float f32x2;
typedef __attribute__((ext_vector_type(6))) unsigned u32x6;
typedef __attribute__((ext_vector_type(32))) float f32x32;
#define PEER_LOAD(R4, R2, base, k0) { _Pragma("unroll") for (int kk = 0; kk < 4; ++kk) { \
    const int e_ = __builtin_amdgcn_readfirstlane(we[(k0) + kk]); \
    R4[kk] = *(const uint4*)((base) + (size_t)e_ * 1024 + lane * 16); } }
#define FP4P(w, b) __builtin_amdgcn_cvt_scalef32_pk_f32_fp4((w), 1.0f, (b))
DEV float dot_row(uint4 a, uint2, const f32x2 (&hv)[16]) {
  f32x2 s = {0.f, 0.f};
  s += FP4P(a.x, 0) * hv[0]; s += FP4P(a.x, 1) * hv[1]; s += FP4P(a.x, 2) * hv[2]; s += FP4P(a.x, 3) * hv[3];
  s += FP4P(a.y, 0) * hv[4]; s += FP4P(a.y, 1) * hv[5]; s += FP4P(a.y, 2) * hv[6]; s += FP4P(a.y, 3) * hv[7];
  s += FP4P(a.z, 0) * hv[8]; s += FP4P(a.z, 1) * hv[9]; s += FP4P(a.z, 2) * hv[10]; s += FP4P(a.z, 3) * hv[11];
  s += FP4P(a.w, 0) * hv[12]; s += FP4P(a.w, 1) * hv[13]; s += FP4P(a.w, 2) * hv[14]; s += FP4P(a.w, 3) * hv[15];
  return s.x + s.y;
}
DEV float reduce4(float p0, float p1, float p2, float p3, int lane) {
  const bool up = lane & 32;
  float k0 = (up ? p2 : p0) + __shfl_xor(up ? p0 : p2, 32);
  float k1 = (up ? p3 : p1) + __shfl_xor(up ? p1 : p3, 32);
  const bool u2 = lane & 16;
  float v = (u2 ? k1 : k0) + __shfl_xor(u2 ? k0 : k1, 16);
  v += __shfl_xor(v, 8); v += __shfl_xor(v, 4); v += __shfl_xor(v, 2); v += __shfl_xor(v, 1);
  return v;
}
#define PEER_DOT(R4, R2, k0) { float q0 = dot_row(R4[0], R2[0], hv), q1 = dot_row(R4[1], R2[1], hv), q2 = dot_row(R4[2], R2[2], hv), q3 = dot_row(R4[3], R2[3], hv); \
    float v_ = reduce4(q0, q1, q2, q3, lane); if ((lane & 15) == 0) wk[(k0) + (lane >> 4)] = v_; }
#define PEER_ACC(R4, R2, k0) { _Pragma("unroll") for (int kk = 0; kk < 4; ++kk) { const float w1_ = wk[(k0) + kk]; const f32x2 ww = {w1_, w1_}; const uint4 a_ = R4[kk]; \
    acc[0] += ww * FP4P(a_.x, 0); acc[1] += ww * FP4P(a_.x, 1); acc[2] += ww * FP4P(a_.x, 2); acc[3] += ww * FP4P(a_.x, 3); \
    acc[4] += ww * FP4P(a_.y, 0); acc[5] += ww * FP4P(a_.y, 1); acc[6] += ww * FP4P(a_.y, 2); acc[7] += ww * FP4P(a_.y, 3); \
    acc[8] += ww * FP4P(a_.z, 0); acc[9] += ww * FP4P(a_.z, 1); acc[10] += ww * FP4P(a_.z, 2); acc[11] += ww * FP4P(a_.z, 3); \
    acc[12] += ww * FP4P(a_.w, 0); acc[13] += ww * FP4P(a_.w, 1); acc[14] += ww * FP4P(a_.w, 2); acc[15] += ww * FP4P(a_.w, 3); } }
#define WAVE_FENCE() { __builtin_amdgcn_fence(__ATOMIC_ACQ_REL, "wavefront"); __builtin_amdgcn_wave_barrier(); }

DEV void phase_peer(const Params& p, int layer, char* smem, bool last) {
  const int lane = threadIdx.x & 63, w = threadIdx.x >> 6;
  int* we = (int*)smem + w * 64;
  float* wg = (float*)smem + w * 64 + 16;
  float* wk = (float*)smem + w * 64 + 32;
  int ci = 0, cj = 0; bool valid = false;
  { int r = lane; for (int i = 0; i < 16; ++i) { int n = 16 / (i + 1); if (r < n) { ci = i; cj = r; valid = true; break; } r -= n; } }
  const unsigned char* U = p.tab + (size_t)(layer * 2) * 16384 * 1024;
  const unsigned char* V = U + (size_t)16384 * 1024;
  const float* su = p.tsc + (size_t)(layer * 2) * 16384; const float* sv_ = su + 16384;
  const float* g = p.ln_ffn_g + layer * 2048; const float* bta = p.ln_ffn_b + layer * 2048;
  for (int t = blockIdx.x * 8 + w; t < T_; t += gridDim.x * 8) {
    f32x2 hv[16], acc[16];
#pragma unroll
    for (int c = 0; c < 8; ++c) {
      float4 a = *(const float4*)(p.hf + (size_t)t * 2048 + c * 256 + lane * 4);
      hv[c * 2] = (f32x2){a.x, a.y}; hv[c * 2 + 1] = (f32x2){a.z, a.w};
      acc[c * 2] = (f32x2){0.f, 0.f}; acc[c * 2 + 1] = (f32x2){0.f, 0.f};
    }
#pragma unroll 1
    for (int hd = 0; hd < 8; ++hd) {
      const size_t so = ((size_t)t * 8 + hd) * 32;
      float cand = -3.0e38f; int eid = 0;
      if (valid) { cand = p.sv[so + ci] + p.sv[so + 16 + cj]; eid = p.si[so + ci] * 128 + p.si[so + 16 + cj]; }
      int rank = 0;
#pragma unroll
      for (int k = 0; k < 50; ++k) { const float o = __int_as_float(__builtin_amdgcn_readlane(__float_as_int(cand), k)); rank += (o > cand || (o == cand && k < lane)) ? 1 : 0; }
      const float mx = __int_as_float(__builtin_amdgcn_readlane(__float_as_int(cand), 0));
      const bool win = valid && rank < 16;
      const float e = win ? __expf(cand - mx) : 0.f;
      const float gsum = wave_sum(e);
      if (win) { we[rank] = eid; wg[rank] = e / gsum; }
      WAVE_FENCE();
      uint4 ra4[4], rb4[4]; uint2 ra2[4], rb2[4];
      PEER_LOAD(ra4, ra2, U, 0); PEER_LOAD(rb4, rb2, U, 4);
      float scu = 0.f, scv = 0.f;
      if (lane < 16) { const int e_ = we[lane]; scu = su[e_]; scv = sv_[e_]; }
      PEER_DOT(ra4, ra2, 0); PEER_LOAD(ra4, ra2, U, 8);
      PEER_DOT(rb4, rb2, 4); PEER_LOAD(rb4, rb2, U, 12);
      PEER_DOT(ra4, ra2, 8); PEER_LOAD(ra4, ra2, V, 0);
      PEER_DOT(rb4, rb2, 12); PEER_LOAD(rb4, rb2, V, 4);
      WAVE_FENCE();
      if (lane < 16) { const float a = wk[lane] * scu; wk[lane] = wg[lane] * 0.5f * a * (1.f + erff(a * 0.7071067811865476f)) * scv; }
      WAVE_FENCE();
      PEER_ACC(ra4, ra2, 0); PEER_LOAD(ra4, ra2, V, 8);
      PEER_ACC(rb4, rb2, 4); PEER_LOAD(rb4, rb2, V, 12);
      PEER_ACC(ra4, ra2, 8);
      PEER_ACC(rb4, rb2, 12);
      WAVE_FENCE();
    }
    float sm = 0.f;
#pragma unroll
    for (int i = 0; i < 16; ++i) { acc[i] += DN_ALPHA * hv[i]; sm += acc[i].x + acc[i].y; }
    const float mu = wave_sum(sm) * (1.f / 2048.f);
    float q = 0.f;
#pragma unroll
    for (int i = 0; i < 16; ++i) { float d0 = acc[i].x - mu, d1 = acc[i].y - mu; q += d0 * d0 + d1 * d1; }
    const float rstd = rsqrtf(wave_sum(q) * (1.f / 2048.f) + LN_EPS);
#pragma unroll
    for (int c = 0; c < 8; ++c) {
      const int o = c * 256 + lane * 4;
      float4 g0 = *(const float4*)(g + o), b0 = *(const float4*)(bta + o), r0;
      r0.x = (acc[c * 2].x - mu) * rstd * g0.x + b0.x; r0.y = (acc[c * 2].y - mu) * rstd * g0.y + b0.y;
      r0.z = (acc[c * 2 + 1].x - mu) * rstd * g0.z + b0.z; r0.w = (acc[c * 2 + 1].y - mu) * rstd * g0.w + b0.w;
      *(float4*)((last ? p.out : p.hf) + (size_t)t * 2048 + o) = r0;
      if (!last) { uint2 h; h.x = pack2(r0.x, r0.y); h.y = pack2(r0.z, r0.w); *(uint2*)(p.hbf + (size_t)t * 2048 + o) = h; }
    }
  }
}

#ifdef DBG
#define TOKB ((size_t)((blockIdx.x * 1031 + 5000) % 16384))
#define DMAX(idx, v) atomicMax((int*)&dbg[idx], __float_as_int(v))
DEV float blk_sum(float v, float* red) {
  v = wave_sum(v); __syncthreads(); if ((threadIdx.x & 63) == 0) red[threadIdx.x >> 6] = v; __syncthreads();
  float r = 0.f; for (int i = 0; i < 8; ++i) r += red[i]; return r;
}
DEV float blk_max(float v, float* red) {
  v = wave_max(v); __syncthreads(); if ((threadIdx.x & 63) == 0) red[threadIdx.x >> 6] = v; __syncthreads();
  float r = -3e38f; for (int i = 0; i < 8; ++i) r = fmaxf(r, red[i]); return r;
}
__global__ void __launch_bounds__(512) dbg_attn(Params p, float* dbg) {
  __shared__ float qs[128], a[2048], red[8], o_s[128];
  const size_t t = TOKB; const int tid = threadIdx.x, b = (int)(t >> 11), hh = (5 + 5 * blockIdx.x) % 12, bh = b * 12 + hh;
  float la = 0.f, lc = 0.f; for (int i = 0; i < 64; ++i) { la += p.attn_lam[i] * p.attn_lam[64 + i]; lc += p.attn_lam[128 + i] * p.attn_lam[192 + i]; }
  const float lam = expf(la) - expf(lc) + 0.2f;
  if (tid < 128) qs[tid] = bf2f(p.proj[t * PLD + hh * 128 + tid]);
  __syncthreads();
  float s1[4], s2[4], m1 = -3e38f, m2 = -3e38f;
  for (int i = 0; i < 4; ++i) {
    int key = tid + 512 * i; const bf16* kp = p.proj + ((size_t)b * 2048 + key) * PLD + 1536 + hh * 128;
    float x = 0.f, y = 0.f; for (int d = 0; d < 64; ++d) { x += qs[d] * bf2f(kp[d]); y += qs[64 + d] * bf2f(kp[64 + d]); }
    s1[i] = x; s2[i] = y; m1 = fmaxf(m1, x); m2 = fmaxf(m2, y);
  }
  m1 = blk_max(m1, red); m2 = blk_max(m2, red);
  float l1 = 0.f, l2 = 0.f; for (int i = 0; i < 4; ++i) { s1[i] = expf(s1[i] - m1); s2[i] = expf(s2[i] - m2); l1 += s1[i]; l2 += s2[i]; }
  l1 = blk_sum(l1, red); l2 = blk_sum(l2, red);
  for (int i = 0; i < 4; ++i) a[tid + 512 * i] = s1[i] / l1 - lam * s2[i] / l2;
  __syncthreads();
  float o = 0.f;
  if (tid < 128) { const bf16* vp = p.Vt + ((size_t)bh * 128 + tid) * 2048; for (int k = 0; k < 2048; ++k) o += a[k] * bf2f(vp[k]); }
  float ss = blk_sum(tid < 128 ? o * o : 0.f, red);
  float rn = rsqrtf(ss / 128.f + LN_EPS) * 0.8f;
  float err = 0.f, mag = 0.f;
  if (tid < 128) { float e = o * rn * p.attn_hn[hh * 128 + tid]; float g = bf2f(p.hbf[t * 2048 + hh * 128 + tid]); err = fabsf(e - g); mag = fabsf(e); }
  err = blk_max(err, red); mag = blk_max(mag, red);
  if (tid == 0) DMAX(2, err / (mag + 1e-6f));
}
__global__ void __launch_bounds__(512) dbg_topk(Params p, float* dbg, int layer, int idx) {
  __shared__ float qry[128], sc[128];
  const int tid = threadIdx.x; const size_t t = TOKB; const int h = (3 + blockIdx.x) % 8, pp = blockIdx.x & 1;
  for (int k = tid; k < 2048; k += 512) dbg[65536 + blockIdx.x * 2048 + k] = p.hf[t * 2048 + k];
  if (tid < 128) { float x = 0.f; for (int k = 0; k < 2048; ++k) x += p.hf[t * 2048 + k] * p.wq[(size_t)layer * 2048 * 2048 + (size_t)k * 2048 + h * 256 + pp * 128 + tid]; qry[tid] = x; }
  __syncthreads();
  if (tid < 128) { float x = 0.f; const float* sk = p.subk + ((size_t)((layer * 8 + h) * 2 + pp) * 128 + tid) * 128; for (int s = 0; s < 128; ++s) x += qry[s] * sk[s]; sc[tid] = x; }
  __syncthreads();
  if (tid == 0) {
    float err = 0.f; unsigned taken[4] = {0, 0, 0, 0};
    const size_t o = (t * 8 + h) * 32 + pp * 16;
    for (int r = 0; r < 16; ++r) {
      float best = -3e38f; int bi = 0;
      for (int n = 0; n < 128; ++n) if (!((taken[n >> 5] >> (n & 31)) & 1) && sc[n] > best) { best = sc[n]; bi = n; }
      taken[bi >> 5] |= 1u << (bi & 31);
      err = fmaxf(err, fabsf(p.sv[o + r] - best));
      int mi = p.si[o + r]; if (mi < 0 || mi > 127) err = 100.f; else err = fmaxf(err, fabsf(sc[mi] - p.sv[o + r]));
    }
    DMAX(idx, err);
  }
}
__global__ void __launch_bounds__(512) dbg_peer(Params p, float* dbg, int layer, int idx) {
  __shared__ int el[128]; __shared__ float gl[128], wl[128], red[8];
  const int tid = threadIdx.x, lane = tid & 63, w = tid >> 6; const size_t t = TOKB; const float* hrow = dbg + 65536 + blockIdx.x * 2048;
  if (tid < 8) {
    const int h = tid; const size_t o = (t * 8 + h) * 32; bool tk[256];
    float tv[16]; int te[16];
    unsigned taken[8] = {0,0,0,0,0,0,0,0};
    for (int r = 0; r < 16; ++r) {
      float best = -3e38f; int bi = 0;
      for (int c = 0; c < 256; ++c) { float v = p.sv[o + (c >> 4)] + p.sv[o + 16 + (c & 15)]; if (!((taken[c >> 5] >> (c & 31)) & 1) && v > best) { best = v; bi = c; } }
      taken[bi >> 5] |= 1u << (bi & 31);
      gl[h * 16 + r] = best; el[h * 16 + r] = p.si[o + (bi >> 4)] * 128 + p.si[o + 16 + (bi & 15)];
    }
    float mx = gl[h * 16], sm = 0.f; for (int r = 0; r < 16; ++r) sm += expf(gl[h * 16 + r] - mx);
    for (int r = 0; r < 16; ++r) gl[h * 16 + r] = expf(gl[h * 16 + r] - mx) / sm;
  }
  __syncthreads();
  for (int i = 0; i < 16; ++i) {
    int ix = w * 16 + i; const float* up = p.pu + (size_t)layer * 16384 * 2048 + (size_t)el[ix] * 2048; float x = 0.f;
    for (int k = lane; k < 2048; k += 64) x += hrow[k] * up[k];
    x = wave_sum(x);
    if (lane == 0) wl[ix] = gl[ix] * 0.5f * x * (1.f + erff(x * 0.7071067811865476f));
  }
  __syncthreads();
  float z[4], s = 0.f;
  for (int j = 0; j < 4; ++j) { int d = tid * 4 + j; float f = 0.f; for (int i = 0; i < 128; ++i) f += wl[i] * p.pv[(size_t)layer * 16384 * 2048 + (size_t)el[i] * 2048 + d]; z[j] = DN_ALPHA * hrow[d] + f; s += z[j]; }
  float mu = blk_sum(s, red) / 2048.f; float q = 0.f; for (int j = 0; j < 4; ++j) q += (z[j] - mu) * (z[j] - mu);
  float rstd = rsqrtf(blk_sum(q, red) / 2048.f + LN_EPS);
  float err = 0.f;
  for (int j = 0; j < 4; ++j) { int d = tid * 4 + j; float e = (z[j] - mu) * rstd * p.ln_ffn_g[layer * 2048 + d] + p.ln_ffn_b[layer * 2048 + d]; err = fmaxf(err, fabsf(e - (layer ? p.out : p.hf)[t * 2048 + d])); }
  err = blk_max(err, red);
  if (tid == 0) DMAX(idx, err);
}
__global__ void __launch_bounds__(512) dbg_mlstm(Params p, float* dbg) {
  __shared__ float numl[132], red[8];
  const int k_ = blockIdx.x, tid = threadIdx.x, b = (2 + k_) % 8, hh = (5 + 5 * k_) % 12, c_ = (2 + 3 * k_) % 16, lo = c_ * 128, hi = lo + 127, bh = b * 12 + hh, kd = tid >> 2, vd0 = (tid & 3) * 32;
  for (int dir = 0; dir < 2; ++dir) {
    float C[32]; for (int e = 0; e < 32; ++e) C[e] = 0.f; float n = 0.f, m = 0.f, err = 0.f, mag = 0.f;
    const float* dump = p.mst + 4096 + k_ * 32768 + dir * 16384;
    for (int sp = 0; sp < 2048; ++sp) {
      const int s = dir ? 2047 - sp : sp; if (dir == 0 ? (s > hi) : (s < lo)) break;
      const size_t t = (size_t)b * 2048 + s;
      const float ig = p.gates[t * 48 + (2 * dir) * 12 + hh] + p.ml_gb[(2 * dir) * 12 + hh];
      const float lf = log_sigmoid(p.gates[t * 48 + (2 * dir + 1) * 12 + hh] + p.ml_gb[(2 * dir + 1) * 12 + hh]);
      const float mn = fmaxf(lf + m, ig), dec = expf(lf + m - mn), wv = expf(ig - mn); m = mn;
      const float kk = bf2f(p.proj[t * PLD + 1536 + hh * 128 + kd]);
      for (int e = 0; e < 32; ++e) C[e] = dec * C[e] + wv * kk * bf2f(p.Vt[((size_t)bh * 128 + vd0 + e) * 2048 + s]);
      n = dec * n + wv * kk;
      if (s >= lo && s <= hi) {
        const float q = bf2f(p.proj[t * PLD + hh * 128 + kd]);
        __syncthreads(); if (tid < 132) numl[tid] = 0.f; __syncthreads();
        for (int e = 0; e < 32; ++e) atomicAdd(&numl[vd0 + e], q * C[e]);
        if ((tid & 3) == 0) atomicAdd(&numl[128], q * n);
        __syncthreads();
        if (tid < 128) { float h = numl[tid] / fmaxf(fabsf(numl[128]), expf(-m)); float g = dump[(s - lo) * 128 + tid]; err += fabsf(h - g); mag += fabsf(h); }
      }
    }
    err = blk_sum(err, red); mag = blk_sum(mag, red);
    if (tid == 0) { DMAX(dir, err / (mag + 1e-6f)); dbg[40 + dir * 8 + k_] = err / (mag + 1e-6f); }
  }
}

DEV float blk_dotf(const float* row, const float* W, int ldw, int col, float* red) {
  float x = 0.f; for (int k = threadIdx.x; k < 2048; k += 512) x += row[k] * W[(size_t)k * ldw + col];
  return blk_sum(x, red);
}
DEV void chk(float* dbg, int idx, float got, float exp) { if (threadIdx.x == 0) { float e = fabsf(got - exp) / (0.02f + 0.02f * fabsf(exp)); DMAX(idx, e); } }
__global__ void __launch_bounds__(512) dbg_proj0(Params p, float* dbg) {
  __shared__ float red[8];
  const size_t t = TOKB; const float* xr = p.x + t * 2048; const int b_ = (int)(t >> 11), s_ = (int)(t & 2047);
  const float inv = powf(10000.f, -9.f / 32.f); const float ang = (float)p.pos[t] * inv; const float cs = cosf(ang), sn = sinf(ang);
  { float a = blk_dotf(xr, p.attn_w, 5120, 457, red), b = blk_dotf(xr, p.attn_w, 5120, 489, red);
    chk(dbg, 8, bf2f(p.proj[t * PLD + 457]), (a * cs - b * sn) * 0.125f); chk(dbg, 8, bf2f(p.proj[t * PLD + 489]), (b * cs + a * sn) * 0.125f); }
  { float a = blk_dotf(xr, p.attn_w, 5120, 1536 + 457, red), b = blk_dotf(xr, p.attn_w, 5120, 1536 + 489, red);
    chk(dbg, 9, bf2f(p.proj[t * PLD + 1536 + 457]), (a * cs - b * sn)); chk(dbg, 9, bf2f(p.proj[t * PLD + 1536 + 489]), (b * cs + a * sn)); }
  { float a = blk_dotf(xr, p.attn_w, 5120, 3072 + 700, red); chk(dbg, 10, bf2f(p.Vt[((size_t)(b_ * 12 + 5) * 128 + 60) * 2048 + s_]), a); }
  { float a = blk_dotf(xr, p.attn_w, 5120, 4608 + 300, red); chk(dbg, 11, bf2f(p.proj[t * PLD + 3072 + 300]), a * 0.08838834764831845f); }
  { const int r_ = (700 + blockIdx.x * 263) % 2048; const float* mr = p.mem + (size_t)r_ * 2048; float a = blk_dotf(mr, p.memkv_w, 1024, 300, red), b = blk_dotf(mr, p.memkv_w, 1024, 812, red);
    chk(dbg, 12, bf2f(p.memK[(size_t)r_ * 512 + 300]), a); chk(dbg, 12, bf2f(p.memVt[((size_t)((r_ >> 8) * 4 + 2) * 128 + 44) * 256 + (r_ & 255)]), b); }
}
__global__ void __launch_bounds__(512) dbg_memattn(Params p, float* dbg, int qmcol, int idx) {
  __shared__ float qs[128], a[256], red[8];
  const size_t t = TOKB; const int tid = threadIdx.x, b = (int)(t >> 11), mh = blockIdx.x & 3;
  if (tid < 128) qs[tid] = bf2f(p.proj[t * PLD + qmcol + mh * 128 + tid]);
  __syncthreads();
  float sc = -3e38f;
  if (tid < 256) { sc = 0.f; const bf16* kp = p.memK + ((size_t)b * 256 + tid) * 512 + mh * 128; for (int d = 0; d < 128; ++d) sc += qs[d] * bf2f(kp[d]); }
  float mx = blk_max(sc, red); float e = tid < 256 ? expf(sc - mx) : 0.f; float l = blk_sum(e, red);
  if (tid < 256) a[tid] = e / l;
  __syncthreads();
  if (tid < 128) { float o = 0.f; const bf16* vp = p.memVt + ((size_t)(b * 4 + mh) * 128 + tid) * 256; for (int k = 0; k < 256; ++k) o += a[k] * bf2f(vp[k]);
    float g = bf2f(p.hbf[t * 2048 + 1536 + mh * 128 + tid]); float er = fabsf(g - o) / (0.01f + 0.03f * fabsf(o)); atomicMax((int*)&dbg[idx], __float_as_int(er)); }
}
__global__ void __launch_bounds__(512) dbg_z(Params p, float* dbg, int layer, int idx) {
  __shared__ float cr[2048];
  const int tid = threadIdx.x; const size_t t = TOKB;
  for (int k = tid; k < 2048; k += 512) cr[k] = bf2f(p.hbf[t * 2048 + k]);
  __syncthreads();
  const float* hp = layer == 0 ? p.x + t * 2048 : dbg + 131072 + blockIdx.x * 2048;
  const float* W = p.w_out + (size_t)layer * 2048 * 2048;
  for (int j = 0; j < 4; ++j) { int n = tid + 512 * j; float y = 0.f; for (int k = 0; k < 2048; ++k) y += cr[k] * W[(size_t)k * 2048 + n];
    float z = DN_ALPHA * hp[n] + y; dbg[32768 + blockIdx.x * 2048 + n] = z; float er = fabsf(p.hf[t * 2048 + n] - z) / (0.02f + 0.02f * fabsf(z)); atomicMax((int*)&dbg[idx], __float_as_int(er)); }
}
__global__ void __launch_bounds__(512) dbg_ln(Params p, float* dbg, int layer, int idx) {
  __shared__ float red[8];
  const int tid = threadIdx.x; const size_t t = TOKB; const float* z = dbg + 32768 + blockIdx.x * 2048;
  float s = 0.f; for (int j = 0; j < 4; ++j) s += z[tid + 512 * j];
  float mu = blk_sum(s, red) / 2048.f; float q = 0.f; for (int j = 0; j < 4; ++j) { float d = z[tid + 512 * j] - mu; q += d * d; }
  float rstd = rsqrtf(blk_sum(q, red) / 2048.f + LN_EPS);
  for (int j = 0; j < 4; ++j) { int n = tid + 512 * j; float e = (z[n] - mu) * rstd * p.ln_mix_g[layer * 2048 + n] + p.ln_mix_b[layer * 2048 + n];
    float er = fabsf(p.hf[t * 2048 + n] - e) / (0.02f + 0.02f * fabsf(e)); atomicMax((int*)&dbg[idx], __float_as_int(er));
    float er2 = fabsf(bf2f(p.hbf[t * 2048 + n]) - e) / (0.02f + 0.02f * fabsf(e)); atomicMax((int*)&dbg[idx], __float_as_int(er2)); }
}
__global__ void __launch_bounds__(512) dbg_proj1(Params p, float* dbg) {
  __shared__ float red[8];
  const size_t t = TOKB; const float* xr = p.hf + t * 2048; const int b_ = (int)(t >> 11), s_ = (int)(t & 2047);
  for (int k = threadIdx.x; k < 2048; k += 512) dbg[131072 + blockIdx.x * 2048 + k] = xr[k];
  const float sc = 0.08838834764831845f;
  { float a = blk_dotf(xr, p.ml_w, 6704, 200, red); chk(dbg, 16, bf2f(p.proj[t * PLD + 200]), a); }
  { float a = blk_dotf(xr, p.ml_w, 6704, 1536 + 200, red); chk(dbg, 16, bf2f(p.proj[t * PLD + 1536 + 200]), a * sc); }
  { float a = blk_dotf(xr, p.ml_w, 6704, 4608 + 200, red); chk(dbg, 16, bf2f(p.proj[t * PLD + 3072 + 200]), a); }
  { float a = blk_dotf(xr, p.ml_w, 6704, 6144 + 200, red); chk(dbg, 16, bf2f(p.proj[t * PLD + 4608 + 200]), a * sc); }
  { float a = blk_dotf(xr, p.ml_w, 6704, 6656 + 7, red); chk(dbg, 17, p.gates[t * 48 + 7], a); }
  { float a = blk_dotf(xr, p.ml_w, 6704, 6656 + 40, red); chk(dbg, 17, p.gates[t * 48 + 40], a); }
  { float a = blk_dotf(xr, p.ml_w, 6704, 3072 + 700, red); chk(dbg, 17, bf2f(p.Vt[((size_t)(b_ * 12 + 5) * 128 + 60) * 2048 + s_]), a); }
}
__global__ void __launch_bounds__(128) dbg_mlcomb(Params p, float* dbg) {
  __shared__ float red[8];
  const int k_ = blockIdx.x, tid = threadIdx.x, j = (37 + 11 * k_) & 127, hh = (5 + 5 * k_) % 12; const size_t t = (size_t)((2 + k_) % 8) * 2048 + ((2 + 3 * k_) % 16) * 128 + j;
  float h = p.mst[4096 + k_ * 32768 + j * 128 + tid] + p.mst[4096 + k_ * 32768 + 16384 + j * 128 + tid];
  float v = wave_sum(h * h); __syncthreads(); if ((tid & 63) == 0) red[tid >> 6] = v; __syncthreads();
  float rn = rsqrtf((red[0] + red[1]) / 128.f + LN_EPS);
  float o = bf2f(p.proj[t * PLD + 3072 + hh * 128 + tid]);
  float e = h * rn * p.ml_hn[hh * 128 + tid] / (1.f + expf(-o));
  float er = fabsf(bf2f(p.hbf[t * 2048 + hh * 128 + tid]) - e) / (0.02f + 0.02f * fabsf(e)); atomicMax((int*)&dbg[18], __float_as_int(er));
}
__global__ void dbg_init(float* dbg) { if (threadIdx.x < 64) dbg[threadIdx.x] = 0.f; }
__global__ void dbg_final(Params p, float* dbg) {
  const int order[21] = {8, 9, 10, 11, 12, 13, 2, 14, 15, 3, 4, 16, 17, 0, 1, 18, 19, 20, 21, 22, 23};
  const float thr[21] = {1, 1, 1, 1, 1, 1, 0.05f, 1, 1, 0.05f, 0.05f, 1, 1, 0.1f, 0.1f, 1, 1, 1, 1, 0.05f, 0.05f};
  int code = 0;
  for (int i = 20; i >= 0; --i) if (!(dbg[order[i]] < thr[i])) code = i + 1;
  if (code == 14 || code == 15) {
    int wk = 0; float we = -1.f;
    for (int i = 0; i < 16; ++i) if (dbg[40 + i] > we) { we = dbg[40 + i]; wk = i; }
    int cls = we < 0.2f ? 0 : we < 0.5f ? 1 : we < 1.0f ? 2 : we < 2.f ? 3 : 4;
    code = wk * 5 + cls;
  }
  p.out[0] = 1000.f * (10 + code);
}
#endif

#define XB_TMO      128
#define XB_XCNT(j)  (256  + 64 * (j))
#define XB_XSUB(j)  (1280 + 64 * (j))
#define XB_XGEN(j)  (2304 + 64 * (j))
#define XB_TOP      3328
#define XB_TOPGEN   3392
#define XCD_BAR_WORDS 3456
#define XB_SPIN_CAP (1u << 21)
#define LAS __attribute__((address_space(3)))

__device__ __forceinline__ unsigned xb_ld(unsigned* p)              { return __hip_atomic_load(p, __ATOMIC_RELAXED, __HIP_MEMORY_SCOPE_AGENT); }
__device__ __forceinline__ unsigned xb_add(unsigned* p, unsigned v) { return __hip_atomic_fetch_add(p, v, __ATOMIC_RELAXED, __HIP_MEMORY_SCOPE_AGENT); }
__device__ __forceinline__ unsigned xb_xcc_id() { return (unsigned)__builtin_amdgcn_s_getreg((3 << 11) | 20) & 0xFu; }
#define XB_SPIN(cond, bar) do { unsigned _sp = 0; while (cond) { __builtin_amdgcn_s_sleep(1); \
    if ((++_sp & 255u) == 0u) { if (xb_ld(&(bar)[XB_TMO])) break; if (_sp > XB_SPIN_CAP) { atomicAdd(&(bar)[XB_TMO], 1u); break; } } } } while (0)

struct XcdBarrier {
    unsigned* bar; unsigned x;
    volatile LAS unsigned* st;
};

__device__ __forceinline__ XcdBarrier xcd_barrier_post(unsigned* bar, volatile LAS unsigned* st) {
    XcdBarrier b; b.bar = bar; b.x = xb_xcc_id(); b.st = st;
    if (threadIdx.x == 0) (void)xb_add(&bar[XB_XCNT(b.x)], 1u);
    return b;
}
__device__ __forceinline__ void xcd_barrier_complete(unsigned* bar, unsigned x, unsigned& nloc, unsigned& nx) {
    const unsigned G = gridDim.x * gridDim.y * gridDim.z;
    unsigned sum, cnt, mine, sp = 0u;
    for (;;) {
        sum = 0u; cnt = 0u; mine = 0u;
#pragma unroll
        for (unsigned j = 0; j < 16; ++j) { const unsigned c = xb_ld(&bar[XB_XCNT(j)]); sum += c; cnt += (c > 0u) ? 1u : 0u; mine = (j == x) ? c : mine; }
        if (sum == G) break;
        __builtin_amdgcn_s_sleep(1);
        if ((++sp & 255u) == 0u) { if (xb_ld(&bar[XB_TMO])) break; if (sp > XB_SPIN_CAP) { atomicAdd(&bar[XB_TMO], 1u); break; } }
    }
    nloc = mine > 0u ? mine : 1u; nx = cnt > 0u ? cnt : 1u;
}

__device__ __forceinline__ void xcd_barrier(const XcdBarrier& b) {
    asm volatile("s_waitcnt vmcnt(0)" ::: "memory");
    __syncthreads();
    if (threadIdx.x == 0) {
        unsigned* bar = b.bar;
        __builtin_amdgcn_s_waitcnt(0);
        unsigned nloc = b.st[0], nx = b.st[1];
        if (nloc == 0u) { xcd_barrier_complete(bar, b.x, nloc, nx); b.st[0] = nloc; b.st[1] = nx; }
        const unsigned old = xb_add(&bar[XB_XSUB(b.x)], 1u);
        const unsigned gen = old / nloc;
        if (old + 1u == (gen + 1u) * nloc) {
            __builtin_amdgcn_fence(__ATOMIC_RELEASE, "agent");
            asm volatile("s_waitcnt vmcnt(0)" ::: "memory");
            const unsigned og = xb_add(&bar[XB_TOP], 1u);
            const unsigned tg = og / nx;
            if (og + 1u == (tg + 1u) * nx) xb_add(&bar[XB_TOPGEN], 1u);
            else XB_SPIN(xb_ld(&bar[XB_TOPGEN]) == tg, bar);
            __builtin_amdgcn_fence(__ATOMIC_ACQUIRE, "agent");
            xb_add(&bar[XB_XGEN(b.x)], 1u);
            asm volatile("s_waitcnt vmcnt(0)" ::: "memory");
        } else {
            XB_SPIN(xb_ld(&bar[XB_XGEN(b.x)]) == gen, bar);
            __builtin_amdgcn_fence(__ATOMIC_ACQUIRE, "agent");
            asm volatile("s_waitcnt vmcnt(0)" ::: "memory");
        }
    }
    __syncthreads();
}


__global__ void __launch_bounds__(NT) mega(Params p) {
  extern __shared__ __attribute__((aligned(16))) char smem[];
  cg::grid_group grid = cg::this_grid();
  __shared__ uint4 xb_words;
  if (threadIdx.x == 0) xb_words = make_uint4(0u, 0u, 0u, 0u);
  __syncthreads();
  XcdBarrier xb = xcd_barrier_post(p.bar, (volatile LAS unsigned*)&xb_words);
#ifndef PH_MASK
#define PH_MASK 0x7fff
#endif
#ifndef DUP_MASK
#define DUP_MASK 0
#endif
#define RUNPH(n, ...) if constexpr ((PH_MASK >> n) & 1) { if (p.ph_lo <= n && n < p.ph_hi) { __VA_ARGS__; if constexpr ((DUP_MASK >> n) & 1) { __VA_ARGS__; } if (n + 1 < p.ph_hi) { if (n == 0) grid.sync(); else xcd_barrier(xb); } } }
  RUNPH(0, phase_convert(p, smem))
  RUNPH(1, phase_gemm2<EPI_ATTN>(p, p.hbf, p.WtAttn, 64, 20, 0, smem, 0, 1280); phase_gemm<EPI_MEMKV>(p, p.membf, p.WtMemkv, 16, 4, 0, smem, 1280, 1280 + 64))
  RUNPH(2, phase_attn0(p, smem))
  RUNPH(3, phase_gemm2<EPI_OUT>(p, p.hbf, p.WtOut, 64, 8, 0, smem, 0, 512))
  RUNPH(4, phase_ln(p, p.ln_mix_g, p.ln_mix_b, p.x))
  RUNPH(5, phase_gemm<EPI_PEERQ>(p, p.hbf, p.WtQ, 128, 8, 0, smem, 0, 1024))
  RUNPH(6, phase_peer(p, 0, smem, false))
  RUNPH(7, phase_gemm2<EPI_ML>(p, p.hbf, p.WtMl, 64, 27, 1, smem, 0, 64 * 27))
  RUNPH(8, for (int it = blockIdx.x; it < 3072; it += gridDim.x) ml_summary_item(p, it, smem))
  RUNPH(9, for (int it = blockIdx.x; it < 768; it += gridDim.x) ml_scan_item(p, it))
  RUNPH(10, for (int it = blockIdx.x; it < 1536; it += gridDim.x) ml_out_item(p, it, smem); for (int it = blockIdx.x; it < 256; it += gridDim.x) mem_attn_item(p, it, 4608, smem))
  RUNPH(11, phase_gemm2<EPI_OUT>(p, p.hbf, p.WtOut + (size_t)2048 * 2048, 64, 8, 1, smem, 0, 512))
  RUNPH(12, phase_ln(p, p.ln_mix_g + 2048, p.ln_mix_b + 2048, p.hf))
  RUNPH(13, phase_gemm<EPI_PEERQ>(p, p.hbf, p.WtQ + (size_t)2048 * 2048, 128, 8, 1, smem, 0, 1024))
  RUNPH(14, phase_peer(p, 1, smem, true))
}

#ifndef MULTI_LAUNCH
#define MULTI_LAUNCH 0
#endif

extern "C" void kernel_launch(void* const* d_in, const int* in_sizes, int n_in, void* d_out, int out_size, void* d_ws, size_t ws_size, hipStream_t stream) {
  static int grid_blocks = 0;
  if (!grid_blocks) {
    int dev = 0, cus = 0, per_cu = 0;
    hipGetDevice(&dev);
    hipDeviceGetAttribute(&cus, hipDeviceAttributeMultiprocessorCount, dev);
    hipFuncSetAttribute((const void*)mega, hipFuncAttributeMaxDynamicSharedMemorySize, (int)LDS_BYTES);
    hipOccupancyMaxActiveBlocksPerMultiprocessor(&per_cu, mega, NT, LDS_BYTES);
    if (per_cu < 1) per_cu = 1;
    grid_blocks = cus * per_cu;
  }
  Params p{};
  p.x = (const float*)d_in[0]; p.mem = (const float*)d_in[1]; p.pos = (const int*)d_in[2];
  p.attn_w = (const float*)d_in[3]; p.attn_lam = (const float*)d_in[4]; p.attn_hn = (const float*)d_in[5];
  p.ml_w = (const float*)d_in[6]; p.ml_gb = (const float*)d_in[7]; p.ml_hn = (const float*)d_in[8];
  p.memkv_w = (const float*)d_in[9]; p.w_out = (const float*)d_in[10]; p.ln_mix_g = (const float*)d_in[11]; p.ln_mix_b = (const float*)d_in[12];
  p.wq = (const float*)d_in[13]; p.subk = (const float*)d_in[14]; p.pu = (const float*)d_in[15]; p.pv = (const float*)d_in[16];
  p.ln_ffn_g = (const float*)d_in[17]; p.ln_ffn_b = (const float*)d_in[18];
  p.out = (float*)d_out;
  char* w = (char*)d_ws; size_t off = 0;
  auto take = [&](size_t bytes) { char* r = w + off; off += (bytes + 255) & ~(size_t)255; return r; };
  p.tab = (unsigned char*)take((size_t)4 * 16384 * 1536);
  p.tsc = (float*)take((size_t)4 * 16384 * 4);
  p.ybf = (bf16*)take((size_t)T_ * 2048 * 2);
  p.WtAttn = (bf16*)take((size_t)5120 * 2048 * 2);
  p.WtMl = (bf16*)take((size_t)NMLPAD * 2048 * 2);
  p.WtMemkv = (bf16*)take((size_t)1024 * 2048 * 2);
  p.WtOut = (bf16*)take((size_t)2 * 2048 * 2048 * 2);
  p.WtQ = (bf16*)take((size_t)2 * 2048 * 2048 * 2);
  p.SK = (bf16*)take((size_t)524288 * 2);
  p.membf = (bf16*)take((size_t)2048 * 2048 * 2);
  p.hbf = (bf16*)take((size_t)T_ * 2048 * 2);
  p.proj = (bf16*)take((size_t)T_ * PLD * 2);
  p.Vt = (bf16*)take((size_t)B_ * 12 * 128 * 2048 * 2);
  p.memK = (bf16*)take((size_t)2048 * 512 * 2);
  p.memVt = (bf16*)take((size_t)B_ * 4 * 128 * 256 * 2);
  p.hf = (float*)take((size_t)T_ * 2048 * 4);
  p.gates = (float*)take((size_t)T_ * 48 * 4);
  p.sv = (float*)take((size_t)T_ * 256 * 4);
  p.si = (int*)take((size_t)T_ * 256 * 4);
  p.kvT = (bf16*)take((size_t)3072 * 16384 * 2);
  p.nvec = (float*)take((size_t)3072 * 128 * 4);
  p.scal = (float*)take((size_t)3072 * 2 * 4);
  p.bar = (unsigned*)take((size_t)XCD_BAR_WORDS * 4);
  p.mst = (float*)take((size_t)3072 * 4 + 4000000);
  if (off > ws_size) { fprintf(stderr, "workspace too small: need %zu have %zu\n", off, ws_size); return; }
#if MULTI_LAUNCH
  for (int ph = 0; ph < NPHASE; ++ph) {
    p.ph_lo = ph; p.ph_hi = ph + 1;
    hipLaunchKernelGGL(mega, dim3(grid_blocks), dim3(NT), LDS_BYTES, stream, p);
#ifdef DBG
    float* dbg = p.mst + 300000;
    if (ph == 0) hipLaunchKernelGGL(dbg_init, dim3(1), dim3(64), 0, stream, dbg);
    if (ph == 1) hipLaunchKernelGGL(dbg_proj0, dim3(8), dim3(512), 0, stream, p, dbg);
    if (ph == 2) { hipLaunchKernelGGL(dbg_attn, dim3(8), dim3(512), 0, stream, p, dbg); hipLaunchKernelGGL(dbg_memattn, dim3(8), dim3(512), 0, stream, p, dbg, 3072, 13); }
    if (ph == 3) hipLaunchKernelGGL(dbg_z, dim3(8), dim3(512), 0, stream, p, dbg, 0, 14);
    if (ph == 4) hipLaunchKernelGGL(dbg_ln, dim3(8), dim3(512), 0, stream, p, dbg, 0, 15);
    if (ph == 5) hipLaunchKernelGGL(dbg_topk, dim3(8), dim3(512), 0, stream, p, dbg, 0, 3);
    if (ph == 6) hipLaunchKernelGGL(dbg_peer, dim3(8), dim3(512), 0, stream, p, dbg, 0, 4);
    if (ph == 7) hipLaunchKernelGGL(dbg_proj1, dim3(8), dim3(512), 0, stream, p, dbg);
    if (ph == 10) { hipLaunchKernelGGL(dbg_mlstm, dim3(8), dim3(512), 0, stream, p, dbg); hipLaunchKernelGGL(dbg_mlcomb, dim3(8), dim3(128), 0, stream, p, dbg); hipLaunchKernelGGL(dbg_memattn, dim3(8), dim3(512), 0, stream, p, dbg, 4608, 19); }
    if (ph == 11) hipLaunchKernelGGL(dbg_z, dim3(8), dim3(512), 0, stream, p, dbg, 1, 20);
    if (ph == 12) hipLaunchKernelGGL(dbg_ln, dim3(8), dim3(512), 0, stream, p, dbg, 1, 21);
    if (ph == 13) hipLaunchKernelGGL(dbg_topk, dim3(8), dim3(512), 0, stream, p, dbg, 1, 22);
    if (ph == 14) hipLaunchKernelGGL(dbg_peer, dim3(8), dim3(512), 0, stream, p, dbg, 1, 23);
    if (ph == 14) hipLaunchKernelGGL(dbg_final, dim3(1), dim3(1), 0, stream, p, dbg);
#endif
  }
#else
  p.ph_lo = 0; p.ph_hi = NPHASE;
  hipMemsetAsync(p.bar, 0, (size_t)XCD_BAR_WORDS * 4, stream);
  void* args[] = {&p};
  hipError_t e = hipLaunchCooperativeKernel((void*)mega, dim3(grid_blocks), dim3(NT), args, LDS_BYTES, stream);
  if (e != hipSuccess) fprintf(stderr, "cooperative launch failed: %s (grid %d)\n", hipGetErrorString(e), grid_blocks);
#endif
}
```

```cpp
#include <hip/hip_runtime.h>
#include <hip/hip_cooperative_groups.h>
#include <cstdio>
#include <cstdint>
namespace cg = cooperative_groups;

typedef unsigned short bf16;
typedef __attribute__((ext_vector_type(8))) short bf16x8;
typedef __attribute__((ext_vector_type(16))) float f32x16;
#define DEV __device__ __forceinline__

constexpr int NT = 512;
constexpr int T_ = 16384, D_ = 2048, S_ = 2048, B_ = 8;
constexpr int PLD = 5120;
constexpr int NMLPAD = 6912;
constexpr size_t LDS_BYTES = 147456;
constexpr float DN_ALPHA = 1.4142135623730951f;
constexpr float LN_EPS = 1e-5f;
constexpr int NPHASE = 15;

struct Params {
  const float *x, *mem; const int* pos;
  const float *attn_w, *attn_lam, *attn_hn, *ml_w, *ml_gb, *ml_hn, *memkv_w, *w_out, *ln_mix_g, *ln_mix_b,
      *wq, *subk, *pu, *pv, *ln_ffn_g, *ln_ffn_b;
  float* out;
  unsigned char* tab;
  bf16* ybf;
  bf16 *WtAttn, *WtMl, *WtMemkv, *WtOut, *WtQ, *SK, *membf, *hbf, *proj, *Vt, *memK, *memVt;
  float *hf, *gates, *sv, *nvec, *scal, *mst, *tsc;
  bf16* kvT;
  int* si;
  unsigned* bar;
  int ph_lo, ph_hi;
};

DEV bf16 f2bf(float f) { uint32_t u = __float_as_uint(f); u += 0x7fffu + ((u >> 16) & 1u); return (bf16)(u >> 16); }
DEV float bf2f(bf16 h) { return __uint_as_float(((uint32_t)h) << 16); }
typedef __attribute__((ext_vector_type(2))) __bf16 bf16v2_t;
typedef __attribute__((ext_vector_type(2))) float f32v2_t;
DEV uint32_t pack2(float a, float b) { f32v2_t x = {a, b}; return __builtin_bit_cast(uint32_t, __builtin_convertvector(x, bf16v2_t)); }
DEV float bflo(uint32_t u) { return __uint_as_float(u << 16); }
DEV float bfhi(uint32_t u) { return __uint_as_float(u & 0xffff0000u); }
DEV f32x16 mfma32(bf16x8 a, bf16x8 b, f32x16 c) { return __builtin_amdgcn_mfma_f32_32x32x16_bf16(a, b, c, 0, 0, 0); }
DEV f32x16 zero16() { f32x16 z; for (int i = 0; i < 16; ++i) z[i] = 0.f; return z; }
DEV float wave_sum(float v) { for (int o = 32; o > 0; o >>= 1) v += __shfl_xor(v, o); return v; }
DEV float wave_max(float v) { for (int o = 32; o > 0; o >>= 1) v = fmaxf(v, __shfl_xor(v, o)); return v; }
DEV bf16x8 ld8(const bf16* p) { return *(const bf16x8*)p; }
typedef __attribute__((ext_vector_type(4))) uint32_t u32x4;
DEV bf16x8 mk8(uint32_t a, uint32_t b, uint32_t c, uint32_t d) {
  u32x4 t = {a, b, c, d}; return __builtin_bit_cast(bf16x8, t);
}

DEV void conv_transpose_tile(const float* __restrict__ src, int N, bf16* __restrict__ dst, int tile, char* smem) {
  float* tl = (float*)smem;
  const int nt = tile >> 5, kt = tile & 31, tid = threadIdx.x;
  __syncthreads();
  for (int ps = 0; ps < 8; ++ps) {
    int r = ps * 8 + (tid >> 6), c = tid & 63;
    int n = nt * 64 + c;
    tl[r * 65 + c] = (n < N) ? src[(size_t)(kt * 64 + r) * N + n] : 0.f;
  }
  __syncthreads();
  for (int ps = 0; ps < 8; ++ps) {
    int n = ps * 8 + (tid >> 6), k = tid & 63;
    dst[(size_t)(nt * 64 + n) * 2048 + kt * 64 + k] = f2bf(tl[k * 65 + n]);
  }
}
DEV void conv_lin(const float* __restrict__ src, bf16* __restrict__ dst, size_t item) {
  size_t o = item * 4096 + (size_t)threadIdx.x * 8;
  float4 a = *(const float4*)(src + o), b = *(const float4*)(src + o + 4);
  uint4 r; r.x = pack2(a.x, a.y); r.y = pack2(a.z, a.w); r.z = pack2(b.x, b.y); r.w = pack2(b.z, b.w);
  *(uint4*)(dst + o) = r;
}
DEV void phase_convert(const Params& p, char* smem) {
  const int nTt = 2560 + 3456 + 512 + 2048 + 2048;
  for (int it = blockIdx.x; it < nTt; it += gridDim.x) {
    int t = it;
    if (t < 2560) { conv_transpose_tile(p.attn_w, 5120, p.WtAttn, t, smem); continue; } t -= 2560;
    if (t < 3456) { conv_transpose_tile(p.ml_w, 6704, p.WtMl, t, smem); continue; } t -= 3456;
    if (t < 512) { conv_transpose_tile(p.memkv_w, 1024, p.WtMemkv, t, smem); continue; } t -= 512;
    if (t < 2048) { int l = t >> 10; conv_transpose_tile(p.w_out + (size_t)l * 2048 * 2048, 2048, p.WtOut + (size_t)l * 2048 * 2048, t & 1023, smem); continue; } t -= 2048;
    { int l = t >> 10; conv_transpose_tile(p.wq + (size_t)l * 2048 * 2048, 2048, p.WtQ + (size_t)l * 2048 * 2048, t & 1023, smem); }
  }
  for (int it = blockIdx.x; it < 8192; it += gridDim.x) {
    const int lane = threadIdx.x & 63, row = it * 8 + (threadIdx.x >> 6);
    const int tbl = row >> 14, e = row & 16383, layer = tbl >> 1, which = tbl & 1;
    const float* sp = (which ? p.pv : p.pu) + ((size_t)layer * 16384 + e) * 2048 + lane * 4;
    float x[32];
    float m = 0.f;
#pragma unroll
    for (int c = 0; c < 8; ++c) {
      float4 a = *(const float4*)(sp + c * 256);
      x[c * 4] = a.x; x[c * 4 + 1] = a.y; x[c * 4 + 2] = a.z; x[c * 4 + 3] = a.w;
      m = fmaxf(m, fmaxf(fmaxf(fabsf(a.x), fabsf(a.y)), fmaxf(fabsf(a.z), fabsf(a.w))));
    }
    m = wave_max(m);
    const float inv = m > 0.f ? 6.f / m : 0.f;
    if (lane == 0) p.tsc[row] = m > 0.f ? m * (1.f / 6.f) : 0.f;
    uint32_t wv[4] = {0u, 0u, 0u, 0u};
#pragma unroll
    for (int k = 0; k < 32; ++k) {
      const float y = x[k] * inv, a = fabsf(y);
      float c = a < 2.f ? rintf(a * 2.f) : (a < 4.f ? 4.f + rintf(a - 2.f) : fminf(7.f, 6.f + rintf((a - 4.f) * 0.5f)));
      wv[k >> 3] |= ((uint32_t)c | (y < 0.f ? 8u : 0u)) << ((k & 7) * 4);
    }
    *(uint4*)(p.tab + (size_t)row * 1024 + lane * 16) = make_uint4(wv[0], wv[1], wv[2], wv[3]);
  }
  const int nL = 128 + 1024 + 8192;
  for (int it = blockIdx.x; it < nL; it += gridDim.x) {
    int t = it;
    if (t < 128) { conv_lin(p.subk, p.SK, t); continue; } t -= 128;
    if (t < 1024) { conv_lin(p.mem, p.membf, t); continue; } t -= 1024;
    conv_lin(p.x, p.hbf, t);
  }
}

enum { EPI_ATTN = 0, EPI_ML = 1, EPI_MEMKV = 2, EPI_OUT = 3, EPI_PEERQ = 4 };

template <int EPI>
DEV void epi64(const Params& p, int layer, int cb, int rb0, int l32, int hl, const f32x16& a00, const f32x16& a01, const f32x16& a10, const f32x16& a11) {
  f32x16 acc[2][2]; acc[0][0] = a00; acc[0][1] = a01; acc[1][0] = a10; acc[1][1] = a11;
  if constexpr (EPI == EPI_ATTN || EPI == EPI_ML) {
    int cls;
    float scale = 1.f; int dcol = 0;
    if constexpr (EPI == EPI_ATTN) {
      if (cb < 1536) { cls = 0; scale = 0.125f * 1.4426950408889634f; dcol = cb; }
      else if (cb < 3072) { cls = 1; dcol = cb; }
      else if (cb < 4608) { cls = 3; dcol = cb - 3072; }
      else { cls = 2; scale = 0.08838834764831845f * 1.4426950408889634f; dcol = cb - 4608 + 3072; }
    } else {
      if (cb < 1536) { cls = 2; dcol = cb; }
      else if (cb < 3072) { cls = 2; scale = 0.08838834764831845f; dcol = cb; }
      else if (cb < 4608) { cls = 3; dcol = cb - 3072; }
      else if (cb < 6144) { cls = 2; dcol = cb - 4608 + 3072; }
      else if (cb < 6656) { cls = 2; scale = 0.08838834764831845f * 1.4426950408889634f; dcol = cb - 6144 + 4608; }
      else if (cb < 6720) { cls = 4; }
      else cls = 5;
    }
    if (cls <= 1) {
      const float inv = exp2f(-(float)l32 * (13.287712379549449f / 32.f));
#pragma unroll
      for (int tm = 0; tm < 2; ++tm)
#pragma unroll
        for (int i = 0; i < 16; ++i) {
          int r = rb0 + tm * 32 + (i >> 2) * 8 + hl * 4 + (i & 3);
          float rev = (float)p.pos[r] * inv * 0.15915494309189535f;
          rev -= floorf(rev);
          float sn = __builtin_amdgcn_sinf(rev), cs = __builtin_amdgcn_cosf(rev);
          float t1 = acc[tm][0][i], t2 = acc[tm][1][i];
          p.proj[(size_t)r * PLD + dcol + l32] = f2bf((t1 * cs - t2 * sn) * scale);
          p.proj[(size_t)r * PLD + dcol + 32 + l32] = f2bf((t2 * cs + t1 * sn) * scale);
        }
    } else if (cls == 2) {
#pragma unroll
      for (int tm = 0; tm < 2; ++tm)
#pragma unroll
        for (int tn = 0; tn < 2; ++tn)
#pragma unroll
          for (int i = 0; i < 16; ++i) {
            int r = rb0 + tm * 32 + (i >> 2) * 8 + hl * 4 + (i & 3);
            p.proj[(size_t)r * PLD + dcol + tn * 32 + l32] = f2bf(acc[tm][tn][i] * scale);
          }
    } else if (cls == 3) {
#pragma unroll
      for (int tm = 0; tm < 2; ++tm)
#pragma unroll
        for (int tn = 0; tn < 2; ++tn) {
          int c = dcol + tn * 32 + l32; int hh = c >> 7, d = c & 127;
#pragma unroll
          for (int g = 0; g < 4; ++g) {
            int r = rb0 + tm * 32 + g * 8 + hl * 4; int b = r >> 11, s = r & 2047;
            uint2 v; v.x = pack2(acc[tm][tn][g * 4], acc[tm][tn][g * 4 + 1]); v.y = pack2(acc[tm][tn][g * 4 + 2], acc[tm][tn][g * 4 + 3]);
            *(uint2*)(p.Vt + ((size_t)(b * 12 + hh) * 128 + d) * 2048 + s) = v;
          }
        }
    } else if (cls == 4) {
      if (l32 < 24 || true) {
#pragma unroll
        for (int tm = 0; tm < 2; ++tm)
#pragma unroll
          for (int tn = 0; tn < 2; ++tn) {
            int c = tn * 32 + l32;
            if (c < 48) {
#pragma unroll
              for (int i = 0; i < 16; ++i) {
                int r = rb0 + tm * 32 + (i >> 2) * 8 + hl * 4 + (i & 3);
                p.gates[(size_t)r * 48 + c] = acc[tm][tn][i];
              }
            }
          }
      }
    }
  } else if constexpr (EPI == EPI_MEMKV) {
    if (cb < 512) {
#pragma unroll
      for (int tm = 0; tm < 2; ++tm)
#pragma unroll
        for (int tn = 0; tn < 2; ++tn)
#pragma unroll
          for (int i = 0; i < 16; ++i) {
            int r = rb0 + tm * 32 + (i >> 2) * 8 + hl * 4 + (i & 3);
            p.memK[(size_t)r * 512 + cb + tn * 32 + l32] = f2bf(acc[tm][tn][i]);
          }
    } else {
#pragma unroll
      for (int tm = 0; tm < 2; ++tm)
#pragma unroll
        for (int tn = 0; tn < 2; ++tn) {
          int c = cb - 512 + tn * 32 + l32; int hh = c >> 7, d = c & 127;
#pragma unroll
          for (int g = 0; g < 4; ++g) {
            int r = rb0 + tm * 32 + g * 8 + hl * 4; int b = r >> 8, s = r & 255;
            uint2 v; v.x = pack2(acc[tm][tn][g * 4], acc[tm][tn][g * 4 + 1]); v.y = pack2(acc[tm][tn][g * 4 + 2], acc[tm][tn][g * 4 + 3]);
            *(uint2*)(p.memVt + ((size_t)(b * 4 + hh) * 128 + d) * 256 + s) = v;
          }
        }
    }
  } else if constexpr (EPI == EPI_OUT) {
#pragma unroll
    for (int tm = 0; tm < 2; ++tm)
#pragma unroll
      for (int tn = 0; tn < 2; ++tn)
#pragma unroll
        for (int i = 0; i < 16; ++i) {
          int r = rb0 + tm * 32 + (i >> 2) * 8 + hl * 4 + (i & 3);
          p.ybf[(size_t)r * 2048 + cb + tn * 32 + l32] = f2bf(acc[tm][tn][i]);
        }
  }
}

template <int EPI>
DEV void gemm_tile(const Params& p, const bf16* __restrict__ A, const bf16* __restrict__ Bt, int m0, int n0, int layer, char* smem) {
  bf16* As = (bf16*)smem;
  bf16* Bs = As + 2 * 128 * 72;
  const int tid = threadIdx.x, lane = tid & 63, w = tid >> 6, wm = w >> 2, wn = w & 3, l32 = lane & 31, hl = lane >> 5;
  f32x16 acc[2][2];
  for (int a = 0; a < 2; ++a) for (int b = 0; b < 2; ++b) acc[a][b] = zero16();
  uint4 s0a0, s0a1, s0b0, s0b1, s0b2, s0b3, s1a0, s1a1, s1b0, s1b1, s1b2, s1b3, s2a0, s2a1, s2b0, s2b1, s2b2, s2b3, s3a0, s3a1, s3b0, s3b1, s3b2, s3b3;
  const int lr = tid >> 3, lc = (tid & 7) * 8;
  const bf16* Ap = A + (size_t)(m0 + lr) * 2048 + lc;
  const bf16* Bp = Bt + (size_t)(n0 + lr) * 2048 + lc;
#define G_LOAD(S, k0) { S##a0 = *(const uint4*)(Ap + (k0)); S##a1 = *(const uint4*)(Ap + (size_t)64 * 2048 + (k0)); \
    S##b0 = *(const uint4*)(Bp + (k0)); S##b1 = *(const uint4*)(Bp + (size_t)64 * 2048 + (k0)); S##b2 = *(const uint4*)(Bp + (size_t)128 * 2048 + (k0)); S##b3 = *(const uint4*)(Bp + (size_t)192 * 2048 + (k0)); }
#define G_STORE(S, nb) { bf16* a_ = As + (nb) * 128 * 72 + lr * 72 + lc; bf16* b_ = Bs + (nb) * 256 * 72 + lr * 72 + lc; \
    *(uint4*)a_ = S##a0; *(uint4*)(a_ + 64 * 72) = S##a1; *(uint4*)b_ = S##b0; *(uint4*)(b_ + 64 * 72) = S##b1; *(uint4*)(b_ + 128 * 72) = S##b2; *(uint4*)(b_ + 192 * 72) = S##b3; }
#define G_COMPUTE(buf) { const bf16* Ab = As + (buf) * 128 * 72 + (wm * 64 + l32) * 72 + hl * 8; const bf16* Bb = Bs + (buf) * 256 * 72 + (wn * 64 + l32) * 72 + hl * 8; \
    _Pragma("unroll") for (int kk = 0; kk < 4; ++kk) { \
      bf16x8 a0 = ld8(Ab + kk * 16), a1 = ld8(Ab + 32 * 72 + kk * 16); bf16x8 b0 = ld8(Bb + kk * 16), b1 = ld8(Bb + 32 * 72 + kk * 16); \
      acc[0][0] = mfma32(a0, b0, acc[0][0]); acc[0][1] = mfma32(a0, b1, acc[0][1]); acc[1][0] = mfma32(a1, b0, acc[1][0]); acc[1][1] = mfma32(a1, b1, acc[1][1]); } }
  __syncthreads();
  G_LOAD(s0, 0); G_LOAD(s1, 64); G_LOAD(s2, 128); G_LOAD(s3, 192);
  G_STORE(s0, 0);
  __syncthreads();
  for (int kt = 0; kt < 32; kt += 4) {
    if (kt + 4 < 32) G_LOAD(s0, (kt + 4) * 64);
    G_COMPUTE(0); G_STORE(s1, 1); __syncthreads();
    if (kt + 5 < 32) G_LOAD(s1, (kt + 5) * 64);
    G_COMPUTE(1); G_STORE(s2, 0); __syncthreads();
    if (kt + 6 < 32) G_LOAD(s2, (kt + 6) * 64);
    G_COMPUTE(0); G_STORE(s3, 1); __syncthreads();
    if (kt + 7 < 32) G_LOAD(s3, (kt + 7) * 64);
    G_COMPUTE(1); if (kt + 4 < 32) G_STORE(s0, 0); __syncthreads();
  }
  const int cb = n0 + wn * 64;
  const int rb0 = m0 + wm * 64;
  if constexpr (EPI != EPI_PEERQ) {
    epi64<EPI>(p, layer, cb, rb0, l32, hl, acc[0][0], acc[0][1], acc[1][0], acc[1][1]);
  } else {
    __builtin_amdgcn_sched_barrier(0);
    const int head = n0 >> 8;
    bf16* ql = (bf16*)smem;
    bf16* skl = ql + 128 * 264;
#pragma unroll
    for (int tm = 0; tm < 2; ++tm)
#pragma unroll
      for (int tn = 0; tn < 2; ++tn)
#pragma unroll
        for (int i = 0; i < 16; ++i) {
          int r = wm * 64 + tm * 32 + (i >> 2) * 8 + hl * 4 + (i & 3);
          ql[r * 264 + wn * 64 + tn * 32 + l32] = f2bf(acc[tm][tn][i]);
        }
    const bf16* sksrc = p.SK + (size_t)(layer * 8 + head) * 2 * 128 * 128;
#pragma unroll 2
    for (int i = 0; i < 8; ++i) {
      int q = tid + i * 512; int row = q >> 4, cc = (q & 15) * 8;
      *(uint4*)(skl + row * 136 + cc) = *(const uint4*)(sksrc + row * 128 + cc);
    }
    __syncthreads();
    for (int a = 0; a < 2; ++a) for (int b = 0; b < 2; ++b) acc[a][b] = zero16();
    const int pp = wn >> 1;
    const bf16* Ab = ql + (wm * 64 + l32) * 264 + pp * 128 + hl * 8;
    const bf16* Bb = skl + (wn * 64 + l32) * 136 + hl * 8;
#pragma unroll
    for (int kk = 0; kk < 8; ++kk) {
      bf16x8 a0 = ld8(Ab + kk * 16), a1 = ld8(Ab + 32 * 264 + kk * 16);
      bf16x8 b0 = ld8(Bb + kk * 16), b1 = ld8(Bb + 32 * 136 + kk * 16);
      acc[0][0] = mfma32(a0, b0, acc[0][0]);
      acc[0][1] = mfma32(a0, b1, acc[0][1]);
      acc[1][0] = mfma32(a1, b0, acc[1][0]);
      acc[1][1] = mfma32(a1, b1, acc[1][1]);
    }
    __syncthreads();
    uint32_t* sc = (uint32_t*)smem;
#pragma unroll
    for (int tm = 0; tm < 2; ++tm)
#pragma unroll
      for (int tn = 0; tn < 2; ++tn)
#pragma unroll
        for (int i = 0; i < 16; ++i) {
          int r = wm * 64 + tm * 32 + (i >> 2) * 8 + hl * 4 + (i & 3);
          const int col = wn * 64 + tn * 32 + l32;
          uint32_t u = __float_as_uint(acc[tm][tn][i]);
          u = (u & 0x80000000u) ? ~u : (u | 0x80000000u);
          sc[r * 260 + col] = (u & ~127u) | (uint32_t)(127 - (col & 127));
        }
    __syncthreads();
    const int sub = lane & 15;
    for (int rd = 0; rd < 8; ++rd) {
      int pr = rd * 32 + w * 4 + (lane >> 4);
      int tok = pr >> 1, ph = pr & 1;
      const uint32_t* src = sc + tok * 260 + ph * 128 + sub * 8;
      uint4 v0 = *(const uint4*)src, v1 = *(const uint4*)(src + 4);
      uint32_t v[8] = {v0.x, v0.y, v0.z, v0.w, v1.x, v1.y, v1.z, v1.w};
      uint32_t mykey = 0;
#define CE_(i, j) { const uint32_t hi_ = max(v[i], v[j]), lo_ = min(v[i], v[j]); v[i] = hi_; v[j] = lo_; }
      CE_(0, 1) CE_(2, 3) CE_(4, 5) CE_(6, 7)
      CE_(0, 2) CE_(1, 3) CE_(4, 6) CE_(5, 7)
      CE_(1, 2) CE_(5, 6)
      CE_(0, 4) CE_(1, 5) CE_(2, 6) CE_(3, 7)
      CE_(2, 4) CE_(3, 5)
      CE_(1, 2) CE_(3, 4) CE_(5, 6)
#undef CE_
      for (int it = 0; it < 16; ++it) {
        uint32_t m = v[0];
        m = max(m, (uint32_t)__builtin_amdgcn_update_dpp(0, (int)m, 0x128, 0xF, 0xF, false));
        m = max(m, (uint32_t)__builtin_amdgcn_update_dpp(0, (int)m, 0x124, 0xF, 0xF, false));
        m = max(m, (uint32_t)__builtin_amdgcn_update_dpp(0, (int)m, 0x122, 0xF, 0xF, false));
        m = max(m, (uint32_t)__builtin_amdgcn_update_dpp(0, (int)m, 0x121, 0xF, 0xF, false));
        if (sub == it) mykey = m;
        const bool pop = (v[0] == m);
#pragma unroll
        for (int j = 0; j < 7; ++j) v[j] = pop ? v[j + 1] : v[j];
        v[7] = pop ? 0u : v[7];
      }
      uint32_t vb = mykey & ~127u;
      vb = (vb & 0x80000000u) ? (vb & 0x7fffffffu) : ~vb;
      size_t o = ((size_t)(m0 + tok) * 8 + head) * 32 + ph * 16 + sub;
      p.sv[o] = __uint_as_float(vb); p.si[o] = 127 - (int)(mykey & 127u);
    }
  }
}

template <int EPI>
DEV void phase_gemm(const Params& p, const bf16* A, const bf16* Bt, int mtiles, int ntiles, int layer, char* smem, int base, int total) {
  for (int it = blockIdx.x; it < total; it += gridDim.x) {
    int t = it - base;
    if (t < 0 || t >= mtiles * ntiles) continue;
    int mt = t % mtiles, nt = t / mtiles;
    gemm_tile<EPI>(p, A, Bt, mt * 128, nt * 256, layer, smem);
  }
}

template <int EPI>
DEV void gemm_tile2(const Params& p, const bf16* __restrict__ A, const bf16* __restrict__ Bt, int m0, int n0, int layer, char* smem) {
  bf16* As = (bf16*)smem;
  bf16* Bs = As + 2 * 256 * 72;
  const int tid = threadIdx.x, lane = tid & 63, w = tid >> 6, wm = w >> 1, wn = w & 1, l32 = lane & 31, hl = lane >> 5;
  f32x16 acc[2][4];
#pragma unroll
  for (int a = 0; a < 2; ++a)
#pragma unroll
    for (int b = 0; b < 4; ++b) acc[a][b] = zero16();
  uint4 t0a0, t0a1, t0a2, t0a3, t0b0, t0b1, t0b2, t0b3;
  const int lr = tid >> 3, lc = (tid & 7) * 8;
  const bf16* Ap = A + (size_t)(m0 + lr) * 2048 + lc;
  const bf16* Bp = Bt + (size_t)(n0 + lr) * 2048 + lc;
#define H_LOAD(S, KOFF) { S##a0 = *(const uint4*)(Ap + (KOFF)); S##a1 = *(const uint4*)(Ap + (size_t)64 * 2048 + (KOFF)); S##a2 = *(const uint4*)(Ap + (size_t)128 * 2048 + (KOFF)); S##a3 = *(const uint4*)(Ap + (size_t)192 * 2048 + (KOFF)); \
    S##b0 = *(const uint4*)(Bp + (KOFF)); S##b1 = *(const uint4*)(Bp + (size_t)64 * 2048 + (KOFF)); S##b2 = *(const uint4*)(Bp + (size_t)128 * 2048 + (KOFF)); S##b3 = *(const uint4*)(Bp + (size_t)192 * 2048 + (KOFF)); }
#define H_STORE(S, nb) { bf16* a_ = As + (nb) * 256 * 72 + lr * 72 + lc; bf16* b_ = Bs + (nb) * 256 * 72 + lr * 72 + lc; \
    *(uint4*)a_ = S##a0; *(uint4*)(a_ + 64 * 72) = S##a1; *(uint4*)(a_ + 128 * 72) = S##a2; *(uint4*)(a_ + 192 * 72) = S##a3; \
    *(uint4*)b_ = S##b0; *(uint4*)(b_ + 64 * 72) = S##b1; *(uint4*)(b_ + 128 * 72) = S##b2; *(uint4*)(b_ + 192 * 72) = S##b3; }
#define H_FRAGS(F, Ab, Bb, kk) { F##a0 = ld8(Ab + (kk) * 16); F##a1 = ld8(Ab + 32 * 72 + (kk) * 16); \
    F##b0 = ld8(Bb + (kk) * 16); F##b1 = ld8(Bb + 32 * 72 + (kk) * 16); F##b2 = ld8(Bb + 64 * 72 + (kk) * 16); F##b3 = ld8(Bb + 96 * 72 + (kk) * 16); }
#define H_MFMA8(F) { acc[0][0] = mfma32(F##a0, F##b0, acc[0][0]); acc[0][1] = mfma32(F##a0, F##b1, acc[0][1]); acc[0][2] = mfma32(F##a0, F##b2, acc[0][2]); acc[0][3] = mfma32(F##a0, F##b3, acc[0][3]); \
    acc[1][0] = mfma32(F##a1, F##b0, acc[1][0]); acc[1][1] = mfma32(F##a1, F##b1, acc[1][1]); acc[1][2] = mfma32(F##a1, F##b2, acc[1][2]); acc[1][3] = mfma32(F##a1, F##b3, acc[1][3]); }
#define H_SCHED_RM() {}
#define H_COMPUTE(buf) { const bf16* Ab = As + (buf) * 256 * 72 + (wm * 64 + l32) * 72 + hl * 8; const bf16* Bb = Bs + (buf) * 256 * 72 + (wn * 128 + l32) * 72 + hl * 8; \
    bf16x8 fa0, fa1, fb0, fb1, fb2, fb3, ga0, ga1, gb0, gb1, gb2, gb3; \
    H_FRAGS(f, Ab, Bb, 0); \
    H_FRAGS(g, Ab, Bb, 1); H_MFMA8(f); H_SCHED_RM(); \
    H_FRAGS(f, Ab, Bb, 2); H_MFMA8(g); H_SCHED_RM(); \
    H_FRAGS(g, Ab, Bb, 3); H_MFMA8(f); H_SCHED_RM(); \
    H_MFMA8(g); }
  __syncthreads();
  H_LOAD(t0, 0);
  H_STORE(t0, 0);
  H_LOAD(t0, 64);
  __syncthreads();
  for (int kt = 0; kt < 32; kt += 2) {
    H_STORE(t0, 1);
    if (kt + 2 < 32) H_LOAD(t0, (kt + 2) * 64);
    H_COMPUTE(0); __syncthreads();
    if (kt + 2 < 32) H_STORE(t0, 0);
    if (kt + 3 < 32) H_LOAD(t0, (kt + 3) * 64);
    H_COMPUTE(1); __syncthreads();
  }
  const int rb0 = m0 + wm * 64;
  epi64<EPI>(p, layer, n0 + wn * 128, rb0, l32, hl, acc[0][0], acc[0][1], acc[1][0], acc[1][1]);
  epi64<EPI>(p, layer, n0 + wn * 128 + 64, rb0, l32, hl, acc[0][2], acc[0][3], acc[1][2], acc[1][3]);
}

template <int EPI>
DEV void phase_gemm2(const Params& p, const bf16* A, const bf16* Bt, int mtiles, int ntiles, int layer, char* smem, int base, int total) {
  for (int it = blockIdx.x; it < total; it += gridDim.x) {
    int t = it - base;
    if (t < 0 || t >= mtiles * ntiles) continue;
    int mt = t % mtiles, nt = t / mtiles;
    gemm_tile2<EPI>(p, A, Bt, mt * 256, nt * 256, layer, smem);
  }
}

DEV void phase_ln(const Params& p, const float* g, const float* bta, const float* hin) {
  const int lane = threadIdx.x & 63, w = threadIdx.x >> 6;
  for (int t = blockIdx.x * 8 + w; t < T_; t += gridDim.x * 8) {
    float* row = p.hf + (size_t)t * 2048;
    const float* hrow = hin + (size_t)t * 2048;
    const bf16* yrow = p.ybf + (size_t)t * 2048;
    float4 v[8]; float s = 0.f;
#pragma unroll
    for (int c = 0; c < 8; ++c) {
      const float4 hh = *(const float4*)(hrow + c * 256 + lane * 4); const uint2 yy = *(const uint2*)(yrow + c * 256 + lane * 4);
      v[c].x = DN_ALPHA * hh.x + bflo(yy.x); v[c].y = DN_ALPHA * hh.y + bfhi(yy.x); v[c].z = DN_ALPHA * hh.z + bflo(yy.y); v[c].w = DN_ALPHA * hh.w + bfhi(yy.y);
      s += v[c].x + v[c].y + v[c].z + v[c].w;
    }
    float mu = wave_sum(s) * (1.f / 2048.f);
    float q = 0.f;
#pragma unroll
    for (int c = 0; c < 8; ++c) { float a = v[c].x - mu, b = v[c].y - mu, cc = v[c].z - mu, d = v[c].w - mu; q += a * a + b * b + cc * cc + d * d; }
    float rstd = rsqrtf(wave_sum(q) * (1.f / 2048.f) + LN_EPS);
#pragma unroll
    for (int c = 0; c < 8; ++c) {
      int o = c * 256 + lane * 4;
      float4 gg = *(const float4*)(g + o), bb = *(const float4*)(bta + o), r;
      r.x = (v[c].x - mu) * rstd * gg.x + bb.x; r.y = (v[c].y - mu) * rstd * gg.y + bb.y;
      r.z = (v[c].z - mu) * rstd * gg.z + bb.z; r.w = (v[c].w - mu) * rstd * gg.w + bb.w;
      *(float4*)(row + o) = r;
      uint2 h; h.x = pack2(r.x, r.y); h.y = pack2(r.z, r.w);
      *(uint2*)(p.hbf + (size_t)t * 2048 + o) = h;
    }
  }
}

template <int DQ, int NMAP>
DEV void attn_core(const bf16* __restrict__ Qp, int ldq, const bf16* __restrict__ Kp, int ldk,
                   const bf16* __restrict__ Vtp, int ldvt, int nkeys, char* smem, f32x16 (&o)[4], float& ltot) {
  bf16* Ks = (bf16*)smem;
  bf16* Vs = Ks + 2 * 64 * 136;
  const int tid = threadIdx.x, lane = tid & 63, w = tid >> 6, l32 = lane & 31, hl = lane >> 5;
  const int qg = NMAP == 2 ? (w & 3) : w, mp = NMAP == 2 ? (w >> 2) : 0;
  bf16x8 qf[DQ / 16];
#pragma unroll
  for (int kk = 0; kk < DQ / 16; ++kk) qf[kk] = ld8(Qp + (size_t)(qg * 32 + l32) * ldq + mp * DQ + kk * 16 + hl * 8);
#pragma unroll
  for (int d = 0; d < 4; ++d) o[d] = zero16();
  float m_run = -1e30f, l_run = 0.f;
  uint4 rk0, rk1, rv0, rv1;
  const int kr = tid >> 4, kc = (tid & 15) * 8;
  const int vr = tid >> 3, vc = (tid & 7) * 8;
  const bf16* Kg = Kp + (size_t)kr * ldk + kc;
  const bf16* Vg = Vtp + (size_t)vr * ldvt + vc;
  __syncthreads();
  rk0 = *(const uint4*)(Kg); rk1 = *(const uint4*)(Kg + (size_t)32 * ldk);
  rv0 = *(const uint4*)(Vg); rv1 = *(const uint4*)(Vg + (size_t)64 * ldvt);
  *(uint4*)(Ks + kr * 136 + kc) = rk0; *(uint4*)(Ks + (kr + 32) * 136 + kc) = rk1;
  *(uint4*)(Vs + vr * 72 + vc) = rv0; *(uint4*)(Vs + (vr + 64) * 72 + vc) = rv1;
  __syncthreads();
  const int ntile = nkeys >> 6;
  for (int kt = 0; kt < ntile; ++kt) {
    const int buf = kt & 1;
    if (kt + 1 < ntile) {
      const int k0 = (kt + 1) * 64;
      rk0 = *(const uint4*)(Kg + (size_t)k0 * ldk); rk1 = *(const uint4*)(Kg + (size_t)(k0 + 32) * ldk);
      rv0 = *(const uint4*)(Vg + k0); rv1 = *(const uint4*)(Vg + (size_t)64 * ldvt + k0);
    }
    const bf16* Kb = Ks + buf * 64 * 136 + l32 * 136 + mp * DQ + hl * 8;
    const bf16* Vb = Vs + buf * 128 * 72 + l32 * 72 + hl * 4;
    f32x16 s[2];
#pragma unroll
    for (int st = 0; st < 2; ++st) {
      s[st] = zero16();
#pragma unroll
      for (int kk = 0; kk < DQ / 16; ++kk) s[st] = mfma32(ld8(Kb + st * 32 * 136 + kk * 16), qf[kk], s[st]);
    }
    float mx = s[0][0];
#pragma unroll
    for (int i = 0; i < 16; ++i) { mx = fmaxf(mx, s[0][i]); mx = fmaxf(mx, s[1][i]); }
    mx = fmaxf(mx, __shfl_xor(mx, 32));
    float mnew = fmaxf(m_run, mx);
    float alpha = __builtin_amdgcn_exp2f(m_run - mnew); m_run = mnew;
    float rs = 0.f;
#pragma unroll
    for (int i = 0; i < 16; ++i) { s[0][i] = __builtin_amdgcn_exp2f(s[0][i] - mnew); s[1][i] = __builtin_amdgcn_exp2f(s[1][i] - mnew); rs += s[0][i] + s[1][i]; }
    l_run = l_run * alpha + rs;
    if (__builtin_amdgcn_ballot_w64(alpha != 1.f) != 0) {
#pragma unroll
      for (int d = 0; d < 4; ++d)
#pragma unroll
        for (int i = 0; i < 16; ++i) o[d][i] *= alpha;
    }
#pragma unroll
    for (int st = 0; st < 2; ++st)
#pragma unroll
      for (int hs = 0; hs < 2; ++hs) {
        bf16x8 pb = mk8(pack2(s[st][hs * 8 + 0], s[st][hs * 8 + 1]), pack2(s[st][hs * 8 + 2], s[st][hs * 8 + 3]),
                        pack2(s[st][hs * 8 + 4], s[st][hs * 8 + 5]), pack2(s[st][hs * 8 + 6], s[st][hs * 8 + 7]));
#pragma unroll
        for (int d = 0; d < 4; ++d) {
          const bf16* vp = Vb + d * 32 * 72 + st * 32 + hs * 16;
          uint2 x0 = *(const uint2*)vp, x1 = *(const uint2*)(vp + 8);
          o[d] = mfma32(mk8(x0.x, x0.y, x1.x, x1.y), pb, o[d]);
        }
      }
    if (kt + 1 < ntile) {
      const int nb = buf ^ 1;
      *(uint4*)(Ks + nb * 64 * 136 + kr * 136 + kc) = rk0; *(uint4*)(Ks + nb * 64 * 136 + (kr + 32) * 136 + kc) = rk1;
      *(uint4*)(Vs + nb * 128 * 72 + vr * 72 + vc) = rv0; *(uint4*)(Vs + nb * 128 * 72 + (vr + 64) * 72 + vc) = rv1;
    }
    __syncthreads();
  }
  ltot = l_run + __shfl_xor(l_run, 32);
}

DEV void mem_attn_item(const Params& p, int it, int qmcol, char* smem) {
  const int b = it >> 5, mh = (it >> 3) & 3, qb = it & 7;
  const int lane = threadIdx.x & 63, w = threadIdx.x >> 6, l32 = lane & 31, hl = lane >> 5;
  f32x16 o[4]; float lt;
  const size_t t0 = (size_t)b * 2048 + qb * 256;
  attn_core<128, 1>(p.proj + t0 * PLD + qmcol + mh * 128, PLD, p.memK + (size_t)b * 256 * 512 + mh * 128, 512,
                    p.memVt + (size_t)(b * 4 + mh) * 128 * 256, 256, 256, smem, o, lt);
  const float inv = 1.f / lt;
  bf16* dst = p.hbf + (t0 + w * 32 + l32) * 2048 + 1536 + mh * 128;
#pragma unroll
  for (int d = 0; d < 4; ++d)
#pragma unroll
    for (int g = 0; g < 4; ++g) {
      uint2 v; v.x = pack2(o[d][g * 4] * inv, o[d][g * 4 + 1] * inv); v.y = pack2(o[d][g * 4 + 2] * inv, o[d][g * 4 + 3] * inv);
      *(uint2*)(dst + d * 32 + g * 8 + hl * 4) = v;
    }
}

DEV void diff_attn_item(const Params& p, int it, float lam, char* smem) {
  const int qb = it & 15, hh = (it >> 4) % 12, b = it / 192;
  const int lane = threadIdx.x & 63, w = threadIdx.x >> 6, l32 = lane & 31, hl = lane >> 5;
  const int qg = w & 3, mp = w >> 2;
  f32x16 o[4]; float lt;
  const size_t t0 = (size_t)b * 2048 + qb * 128;
  attn_core<64, 2>(p.proj + t0 * PLD + hh * 128, PLD, p.proj + (size_t)b * 2048 * PLD + 1536 + hh * 128, PLD,
                   p.Vt + (size_t)(b * 12 + hh) * 128 * 2048, 2048, 2048, smem, o, lt);
  const float inv = 1.f / lt;
  float* ob = (float*)smem;
  if (mp == 1) {
#pragma unroll
    for (int d = 0; d < 4; ++d)
#pragma unroll
      for (int g = 0; g < 4; ++g) {
        float4 v; v.x = o[d][g * 4] * inv; v.y = o[d][g * 4 + 1] * inv; v.z = o[d][g * 4 + 2] * inv; v.w = o[d][g * 4 + 3] * inv;
        *(float4*)(ob + (qg * 32 + l32) * 132 + d * 32 + g * 8 + hl * 4) = v;
      }
  }
  __syncthreads();
  if (mp == 0) {
    float ss = 0.f;
#pragma unroll
    for (int d = 0; d < 4; ++d)
#pragma unroll
      for (int g = 0; g < 4; ++g) {
        float4 v = *(const float4*)(ob + (qg * 32 + l32) * 132 + d * 32 + g * 8 + hl * 4);
        o[d][g * 4] = o[d][g * 4] * inv - lam * v.x; o[d][g * 4 + 1] = o[d][g * 4 + 1] * inv - lam * v.y;
        o[d][g * 4 + 2] = o[d][g * 4 + 2] * inv - lam * v.z; o[d][g * 4 + 3] = o[d][g * 4 + 3] * inv - lam * v.w;
        ss += o[d][g * 4] * o[d][g * 4] + o[d][g * 4 + 1] * o[d][g * 4 + 1] + o[d][g * 4 + 2] * o[d][g * 4 + 2] + o[d][g * 4 + 3] * o[d][g * 4 + 3];
      }
    ss += __shfl_xor(ss, 32);
    const float rn = rsqrtf(ss * (1.f / 128.f) + LN_EPS) * 0.8f;
    const float* gn = p.attn_hn + hh * 128;
    bf16* dst = p.hbf + (t0 + qg * 32 + l32) * 2048 + hh * 128;
#pragma unroll
    for (int d = 0; d < 4; ++d)
#pragma unroll
      for (int g = 0; g < 4; ++g) {
        int c = d * 32 + g * 8 + hl * 4;
        float4 gg = *(const float4*)(gn + c);
        uint2 v; v.x = pack2(o[d][g * 4] * rn * gg.x, o[d][g * 4 + 1] * rn * gg.y); v.y = pack2(o[d][g * 4 + 2] * rn * gg.z, o[d][g * 4 + 3] * rn * gg.w);
        *(uint2*)(dst + c) = v;
      }
  }
  __syncthreads();
}

DEV void phase_attn0(const Params& p, char* smem) {
  float a = 0.f, c = 0.f;
  for (int i = 0; i < 64; ++i) { a += p.attn_lam[i] * p.attn_lam[64 + i]; c += p.attn_lam[128 + i] * p.attn_lam[192 + i]; }
  const float lam = expf(a) - expf(c) + 0.2f;
  for (int it = blockIdx.x; it < 1536 + 256; it += gridDim.x) {
    if (it < 1536) diff_attn_item(p, it, lam, smem);
    else mem_attn_item(p, it - 1536, 3072, smem);
  }
}

DEV float log_sigmoid(float x) { return fminf(x, 0.f) - log1pf(expf(-fabsf(x))); }

DEV void gate_vectors(const Params& p, int b, int hh, int dir, int c, int lane, float& R0, float& R1, float& C0, float& C1, float& total) {
  const size_t t = (size_t)b * 2048 + c * 128 + lane * 2;
  const int ci = (2 * dir) * 12 + hh, cf = (2 * dir + 1) * 12 + hh;
  float i0 = p.gates[t * 48 + ci] + p.ml_gb[ci], i1 = p.gates[(t + 1) * 48 + ci] + p.ml_gb[ci];
  float f0 = log_sigmoid(p.gates[t * 48 + cf] + p.ml_gb[cf]), f1 = log_sigmoid(p.gates[(t + 1) * 48 + cf] + p.ml_gb[cf]);
  float s = f0 + f1;
  for (int o = 1; o < 64; o <<= 1) { float u = __shfl_up(s, o); if (lane >= o) s += u; }
  total = __shfl(s, 63);
  float p1 = s, p0 = s - f1;
  if (dir == 0) { R0 = p0; R1 = p1; }
  else { R0 = total - (p0 - f0); R1 = total - (p1 - f1); }
  C0 = i0 - R0; C1 = i1 - R1;
}

DEV void ml_summary_item(const Params& p, int it, char* smem) {
  const int c = it & 15, dir = (it >> 4) & 1, bh = it >> 5, hh = bh % 12, b = bh / 12;
  bf16* kwT = (bf16*)smem;
  bf16* vT = kwT + 128 * 136;
  float* wa = (float*)(vT + 128 * 136);
  const int tid = threadIdx.x, lane = tid & 63, w = tid >> 6, l32 = lane & 31, hl = lane >> 5;
  __syncthreads();
  if (w == 0) {
    float R0, R1, C0, C1, tot; gate_vectors(p, b, hh, dir, c, lane, R0, R1, C0, C1, tot);
    float a0 = tot + C0, a1 = tot + C1;
    float am = wave_max(fmaxf(a0, a1));
    wa[lane * 2] = expf(a0 - am); wa[lane * 2 + 1] = expf(a1 - am);
    if (lane == 0) { p.scal[it * 2] = tot; p.scal[it * 2 + 1] = am; }
  }
  const size_t t0 = (size_t)b * 2048 + c * 128;
  const bf16* vsrc = p.Vt + (size_t)(b * 12 + hh) * 128 * 2048 + c * 128;
#pragma unroll
  for (int i = 0; i < 4; ++i) { int q = tid + i * 512; int r = q >> 4, cc = (q & 15) * 8; *(uint4*)(vT + r * 136 + cc) = *(const uint4*)(vsrc + (size_t)r * 2048 + cc); }
  __syncthreads();
  const bf16* ksrc = p.proj + t0 * PLD + 1536 + hh * 128;
#pragma unroll
  for (int i = 0; i < 4; ++i) {
    int q = tid + i * 512; int s = q & 127, kc = (q >> 7) * 8;
    uint4 kv = *(const uint4*)(ksrc + (size_t)s * PLD + kc);
    float wgt = wa[s];
    uint32_t u[4] = {kv.x, kv.y, kv.z, kv.w};
#pragma unroll
    for (int j = 0; j < 4; ++j) { kwT[(kc + 2 * j) * 136 + s] = f2bf(bflo(u[j]) * wgt); kwT[(kc + 2 * j + 1) * 136 + s] = f2bf(bfhi(u[j]) * wgt); }
  }
  __syncthreads();
  const int mt = w >> 1, ntb = (w & 1) * 2;
  f32x16 acc[2] = {zero16(), zero16()};
#pragma unroll
  for (int kk = 0; kk < 8; ++kk) {
    bf16x8 a = ld8(vT + (mt * 32 + l32) * 136 + kk * 16 + hl * 8);
#pragma unroll
    for (int n = 0; n < 2; ++n) acc[n] = mfma32(a, ld8(kwT + ((ntb + n) * 32 + l32) * 136 + kk * 16 + hl * 8), acc[n]);
  }
  bf16* dst = p.kvT + (size_t)it * 16384;
#pragma unroll
  for (int n = 0; n < 2; ++n)
#pragma unroll
    for (int i = 0; i < 16; ++i) dst[(mt * 32 + (i >> 2) * 8 + hl * 4 + (i & 3)) * 128 + (ntb + n) * 32 + l32] = f2bf(acc[n][i]);
  if (tid < 128) {
    float s = 0.f;
    for (int j = 0; j < 128; ++j) s += bf2f(kwT[tid * 136 + j]);
    p.nvec[(size_t)it * 128 + tid] = s;
  }
}

DEV void ml_scan_item(const Params& p, int it) {
  const int slab = it & 3, bhd = it >> 2, dir = bhd & 1, tid = threadIdx.x;
  float C[8];
#pragma unroll
  for (int j = 0; j < 8; ++j) C[j] = 0.f;
  float4 Nn = make_float4(0.f, 0.f, 0.f, 0.f);
  float m = 0.f;
  const bool doN = (slab == 0 && tid < 32);
  const size_t eoff = (size_t)slab * 4096 + tid * 8;
  uint4 cur = *(const uint4*)(p.kvT + (size_t)(bhd * 16 + (dir ? 15 : 0)) * 16384 + eoff);
  for (int cc = 0; cc < 16; ++cc) {
    const int c = dir ? 15 - cc : cc;
    const int id9 = bhd * 16 + c;
    uint4 nxt = make_uint4(0u, 0u, 0u, 0u);
    if (cc + 1 < 16) nxt = *(const uint4*)(p.kvT + (size_t)(bhd * 16 + (dir ? 14 - cc : cc + 1)) * 16384 + eoff);
    const float bl = p.scal[id9 * 2], am = p.scal[id9 * 2 + 1];
    uint4 st; st.x = pack2(C[0], C[1]); st.y = pack2(C[2], C[3]); st.z = pack2(C[4], C[5]); st.w = pack2(C[6], C[7]);
    *(uint4*)(p.kvT + (size_t)id9 * 16384 + eoff) = st;
    float4 nn = make_float4(0.f, 0.f, 0.f, 0.f);
    if (doN) { float4* pn = (float4*)(p.nvec + (size_t)id9 * 128 + tid * 4); nn = *pn; *pn = Nn; }
    if (slab == 0 && tid == 0) p.mst[id9] = m;
    const float mn = fmaxf(bl + m, am);
    const float dec = expf(bl + m - mn), ww = expf(am - mn);
    const float kv[8] = {bflo(cur.x), bfhi(cur.x), bflo(cur.y), bfhi(cur.y), bflo(cur.z), bfhi(cur.z), bflo(cur.w), bfhi(cur.w)};
#pragma unroll
    for (int j = 0; j < 8; ++j) C[j] = dec * C[j] + ww * kv[j];
    Nn.x = dec * Nn.x + ww * nn.x; Nn.y = dec * Nn.y + ww * nn.y; Nn.z = dec * Nn.z + ww * nn.z; Nn.w = dec * Nn.w + ww * nn.w;
    m = mn; cur = nxt;
  }
}

DEV void ml_out_item(const Params& p, int it, char* smem) {
  const int c = it & 15, bh = it >> 4, hh = bh % 12, b = bh / 12;
  bf16* ks = (bf16*)smem;
  bf16* vT = ks + 128 * 136;
  bf16* CT = vT + 128 * 136;
  float* vec = (float*)(CT + 2 * 128 * 136);
  float *Rv = vec, *Cv = vec + 256, *Mv = vec + 512, *nS = vec + 768, *msv = vec + 1024;
  const int tid = threadIdx.x, lane = tid & 63, w = tid >> 6, l32 = lane & 31, hl = lane >> 5;
  const int dir = w >> 2, qg = w & 3;
  const size_t t0 = (size_t)b * 2048 + c * 128;
  __syncthreads();
  if (w < 2) {
    const int dr = w;
    const int id9 = (bh * 2 + dr) * 16 + c;
    float R0, R1, C0, C1, tot; gate_vectors(p, b, hh, dr, c, lane, R0, R1, C0, C1, tot);
    const float ms = p.mst[id9];
    float mx = fmaxf(C0, C1), x0, x1;
    if (dr == 0) {
      for (int o = 1; o < 64; o <<= 1) { float u = __shfl_up(mx, o); if (lane >= o) mx = fmaxf(mx, u); }
      float prev = __shfl_up(mx, 1); if (lane == 0) prev = -3.0e38f;
      x0 = fmaxf(prev, C0); x1 = mx;
    } else {
      for (int o = 1; o < 64; o <<= 1) { float u = __shfl_down(mx, o); if (lane + o < 64) mx = fmaxf(mx, u); }
      float nxt = __shfl_down(mx, 1); if (lane == 63) nxt = -3.0e38f;
      x1 = fmaxf(nxt, C1); x0 = mx;
    }
    Rv[dr * 128 + lane * 2] = R0; Rv[dr * 128 + lane * 2 + 1] = R1;
    Cv[dr * 128 + lane * 2] = C0; Cv[dr * 128 + lane * 2 + 1] = C1;
    Mv[dr * 128 + lane * 2] = fmaxf(R0 + ms, R0 + x0); Mv[dr * 128 + lane * 2 + 1] = fmaxf(R1 + ms, R1 + x1);
    nS[dr * 128 + lane * 2] = p.nvec[(size_t)id9 * 128 + lane * 2]; nS[dr * 128 + lane * 2 + 1] = p.nvec[(size_t)id9 * 128 + lane * 2 + 1];
    if (lane == 0) msv[dr] = ms;
  }
  {
    const bf16* ksrc = p.proj + t0 * PLD + 1536 + hh * 128;
    const bf16* vsrc = p.Vt + (size_t)(b * 12 + hh) * 128 * 2048 + c * 128;
#pragma unroll
    for (int i = 0; i < 4; ++i) {
      int q = tid + i * 512; int r = q >> 4, cc = (q & 15) * 8;
      *(uint4*)(ks + r * 136 + cc) = *(const uint4*)(ksrc + (size_t)r * PLD + cc);
      *(uint4*)(vT + r * 136 + cc) = *(const uint4*)(vsrc + (size_t)r * 2048 + cc);
    }
#pragma unroll 1
    for (int dr = 0; dr < 2; ++dr) {
      const bf16* csrc = p.kvT + (size_t)((bh * 2 + dr) * 16 + c) * 16384;
#pragma unroll
      for (int i = 0; i < 4; ++i) {
        int q = tid + i * 512; int r = q >> 4, cc = (q & 15) * 8;
        *(uint4*)(CT + dr * 128 * 136 + r * 136 + cc) = *(const uint4*)(csrc + r * 128 + cc);
      }
    }
  }
  __syncthreads();
  const int j = qg * 32 + l32;
  bf16x8 qf[8];
#pragma unroll
  for (int kk = 0; kk < 8; ++kk) qf[kk] = ld8(p.proj + (t0 + j) * PLD + hh * 128 + kk * 16 + hl * 8);
  f32x16 acc[4];
#pragma unroll
  for (int d = 0; d < 4; ++d) acc[d] = zero16();
  const bf16* Cb = CT + dir * 128 * 136 + l32 * 136 + hl * 8;
#pragma unroll
  for (int d = 0; d < 4; ++d) {
#pragma unroll
    for (int kk = 0; kk < 8; ++kk) acc[d] = mfma32(ld8(Cb + d * 32 * 136 + kk * 16), qf[kk], acc[d]);
    __builtin_amdgcn_sched_barrier(0);
  }
  float qn = 0.f;
#pragma unroll
  for (int kk = 0; kk < 8; ++kk)
#pragma unroll
    for (int e = 0; e < 8; ++e) qn += bf2f((bf16)qf[kk][e]) * nS[dir * 128 + kk * 16 + hl * 8 + e];
  qn += __shfl_xor(qn, 32);
  const float Rj = Rv[dir * 128 + j], Mj = Mv[dir * 128 + j], ms = msv[dir];
  const float wi = __expf(Rj + ms - Mj);
#pragma unroll
  for (int d = 0; d < 4; ++d)
#pragma unroll
    for (int i = 0; i < 16; ++i) acc[d][i] *= wi;
  float den = 0.f;
  const float rowt = Rj - Mj;
#pragma unroll 1
  for (int st = 0; st < 4; ++st) {
    if (dir == 0 ? (st > qg) : (st < qg)) continue;
    f32x16 s = zero16();
#pragma unroll
    for (int kk = 0; kk < 8; ++kk) s = mfma32(ld8(ks + (st * 32 + l32) * 136 + kk * 16 + hl * 8), qf[kk], s);
    __builtin_amdgcn_sched_barrier(0);
#pragma unroll
    for (int i = 0; i < 16; ++i) {
      int sidx = st * 32 + (i >> 2) * 8 + hl * 4 + (i & 3);
      bool ok = dir == 0 ? (sidx <= j) : (sidx >= j);
      float wgt = ok ? __expf(rowt + Cv[dir * 128 + sidx]) : 0.f;
      s[i] *= wgt; den += s[i];
    }
#pragma unroll
    for (int hs = 0; hs < 2; ++hs) {
      bf16x8 pb = mk8(pack2(s[hs * 8 + 0], s[hs * 8 + 1]), pack2(s[hs * 8 + 2], s[hs * 8 + 3]), pack2(s[hs * 8 + 4], s[hs * 8 + 5]), pack2(s[hs * 8 + 6], s[hs * 8 + 7]));
#pragma unroll
      for (int d = 0; d < 4; ++d) {
        const bf16* vp = vT + (d * 32 + l32) * 136 + st * 32 + hs * 16 + hl * 4;
        uint2 x0 = *(const uint2*)vp, x1 = *(const uint2*)(vp + 8);
        acc[d] = mfma32(mk8(x0.x, x0.y, x1.x, x1.y), pb, acc[d]);
      }
      __builtin_amdgcn_sched_barrier(0);
    }
  }
  den += __shfl_xor(den, 32);
  den += wi * qn;
  const float rd = 1.f / fmaxf(fabsf(den), __expf(-Mj));
  __syncthreads();
  float* hb = (float*)CT;
#ifdef DBG
  {
    float* hx = dir == 1 ? hb : (float*)smem;
#pragma unroll
    for (int d = 0; d < 4; ++d)
#pragma unroll
      for (int g = 0; g < 4; ++g) {
        float4 v; v.x = acc[d][g * 4] * rd; v.y = acc[d][g * 4 + 1] * rd; v.z = acc[d][g * 4 + 2] * rd; v.w = acc[d][g * 4 + 3] * rd;
        *(float4*)(hx + j * 132 + d * 32 + g * 8 + hl * 4) = v;
      }
  }
  __syncthreads();
  for (int k = 0; k < 8; ++k) {
    if (it == (((2 + k) % 8) * 12 + (5 + 5 * k) % 12) * 16 + (2 + 3 * k) % 16) {
      float* dd = p.mst + 4096 + k * 32768;
      for (int e = tid; e < 16384; e += 512) { dd[e] = ((float*)smem)[(e >> 7) * 132 + (e & 127)]; dd[16384 + e] = hb[(e >> 7) * 132 + (e & 127)]; }
    }
  }
#else
  if (dir == 1) {
#pragma unroll
    for (int d = 0; d < 4; ++d)
#pragma unroll
      for (int g = 0; g < 4; ++g) {
        float4 v; v.x = acc[d][g * 4] * rd; v.y = acc[d][g * 4 + 1] * rd; v.z = acc[d][g * 4 + 2] * rd; v.w = acc[d][g * 4 + 3] * rd;
        *(float4*)(hb + j * 132 + d * 32 + g * 8 + hl * 4) = v;
      }
  }
  __syncthreads();
#endif
  if (dir == 0) {
    float ss = 0.f;
#pragma unroll
    for (int d = 0; d < 4; ++d)
#pragma unroll
      for (int g = 0; g < 4; ++g) {
        float4 v = *(const float4*)(hb + j * 132 + d * 32 + g * 8 + hl * 4);
        acc[d][g * 4] = acc[d][g * 4] * rd + v.x; acc[d][g * 4 + 1] = acc[d][g * 4 + 1] * rd + v.y;
        acc[d][g * 4 + 2] = acc[d][g * 4 + 2] * rd + v.z; acc[d][g * 4 + 3] = acc[d][g * 4 + 3] * rd + v.w;
        ss += acc[d][g * 4] * acc[d][g * 4] + acc[d][g * 4 + 1] * acc[d][g * 4 + 1] + acc[d][g * 4 + 2] * acc[d][g * 4 + 2] + acc[d][g * 4 + 3] * acc[d][g * 4 + 3];
      }
    ss += __shfl_xor(ss, 32);
    const float rn = rsqrtf(ss * (1.f / 128.f) + LN_EPS);
    const float* gn = p.ml_hn + hh * 128;
    const bf16* osrc = p.proj + (t0 + j) * PLD + 3072 + hh * 128;
    bf16* dst = p.hbf + (t0 + j) * 2048 + hh * 128;
#pragma unroll
    for (int d = 0; d < 4; ++d)
#pragma unroll
      for (int g = 0; g < 4; ++g) {
        int cc = d * 32 + g * 8 + hl * 4;
        float4 gg = *(const float4*)(gn + cc);
        uint2 ov = *(const uint2*)(osrc + cc);
        float o0 = 1.f / (1.f + __expf(-bflo(ov.x))), o1 = 1.f / (1.f + __expf(-bfhi(ov.x))), o2 = 1.f / (1.f + __expf(-bflo(ov.y))), o3 = 1.f / (1.f + __expf(-bfhi(ov.y)));
        uint2 v; v.x = pack2(acc[d][g * 4] * rn * gg.x * o0, acc[d][g * 4 + 1] * rn * gg.y * o1);
        v.y = pack2(acc[d][g * 4 + 2] * rn * gg.z * o2, acc[d][g * 4 + 3] * rn * gg.w * o3);
        *(uint2*)(dst + cc) = v;
      }
  }
  __syncthreads();
}

typedef __attribute__((ext_vector_type(2))) float f32x2;
typedef __attribute__((ext_vector_type(6))) unsigned u32x6;
typedef __attribute__((ext_vector_type(32))) float f32x32;
#define PEER_LOAD(R4, R2, base, k0) { _Pragma("unroll") for (int kk = 0; kk < 4; ++kk) { \
    const int e_ = __builtin_amdgcn_readfirstlane(we[(k0) + kk]); \
    R4[kk] = *(const uint4*)((base) + (size_t)e_ * 1024 + lane * 16); } }
#define FP4P(w, b) __builtin_amdgcn_cvt_scalef32_pk_f32_fp4((w), 1.0f, (b))
DEV float dot_row(uint4 a, uint2, const f32x2 (&hv)[16]) {
  f32x2 s = {0.f, 0.f};
  s += FP4P(a.x, 0) * hv[0]; s += FP4P(a.x, 1) * hv[1]; s += FP4P(a.x, 2) * hv[2]; s += FP4P(a.x, 3) * hv[3];
  s += FP4P(a.y, 0) * hv[4]; s += FP4P(a.y, 1) * hv[5]; s += FP4P(a.y, 2) * hv[6]; s += FP4P(a.y, 3) * hv[7];
  s += FP4P(a.z, 0) * hv[8]; s += FP4P(a.z, 1) * hv[9]; s += FP4P(a.z, 2) * hv[10]; s += FP4P(a.z, 3) * hv[11];
  s += FP4P(a.w, 0) * hv[12]; s += FP4P(a.w, 1) * hv[13]; s += FP4P(a.w, 2) * hv[14]; s += FP4P(a.w, 3) * hv[15];
  return s.x + s.y;
}
DEV float reduce4(float p0, float p1, float p2, float p3, int lane) {
  const bool up = lane & 32;
  float k0 = (up ? p2 : p0) + __shfl_xor(up ? p0 : p2, 32);
  float k1 = (up ? p3 : p1) + __shfl_xor(up ? p1 : p3, 32);
  const bool u2 = lane & 16;
  float v = (u2 ? k1 : k0) + __shfl_xor(u2 ? k0 : k1, 16);
  v += __shfl_xor(v, 8); v += __shfl_xor(v, 4); v += __shfl_xor(v, 2); v += __shfl_xor(v, 1);
  return v;
}
#define PEER_DOT(R4, R2, k0) { float q0 = dot_row(R4[0], R2[0], hv), q1 = dot_row(R4[1], R2[1], hv), q2 = dot_row(R4[2], R2[2], hv), q3 = dot_row(R4[3], R2[3], hv); \
    float v_ = reduce4(q0, q1, q2, q3, lane); if ((lane & 15) == 0) wk[(k0) + (lane >> 4)] = v_; }
#define PEER_ACC(R4, R2, k0) { _Pragma("unroll") for (int kk = 0; kk < 4; ++kk) { const float w1_ = wk[(k0) + kk]; const f32x2 ww = {w1_, w1_}; const uint4 a_ = R4[kk]; \
    acc[0] += ww * FP4P(a_.x, 0); acc[1] += ww * FP4P(a_.x, 1); acc[2] += ww * FP4P(a_.x, 2); acc[3] += ww * FP4P(a_.x, 3); \
    acc[4] += ww * FP4P(a_.y, 0); acc[5] += ww * FP4P(a_.y, 1); acc[6] += ww * FP4P(a_.y, 2); acc[7] += ww * FP4P(a_.y, 3); \
    acc[8] += ww * FP4P(a_.z, 0); acc[9] += ww * FP4P(a_.z, 1); acc[10] += ww * FP4P(a_.z, 2); acc[11] += ww * FP4P(a_.z, 3); \
    acc[12] += ww * FP4P(a_.w, 0); acc[13] += ww * FP4P(a_.w, 1); acc[14] += ww * FP4P(a_.w, 2); acc[15] += ww * FP4P(a_.w, 3); } }
#define WAVE_FENCE() { __builtin_amdgcn_fence(__ATOMIC_ACQ_REL, "wavefront"); __builtin_amdgcn_wave_barrier(); }

DEV void phase_peer(const Params& p, int layer, char* smem, bool last) {
  const int lane = threadIdx.x & 63, w = threadIdx.x >> 6;
  int* we = (int*)smem + w * 64;
  float* wg = (float*)smem + w * 64 + 16;
  float* wk = (float*)smem + w * 64 + 32;
  int ci = 0, cj = 0; bool valid = false;
  { int r = lane; for (int i = 0; i < 16; ++i) { int n = 16 / (i + 1); if (r < n) { ci = i; cj = r; valid = true; break; } r -= n; } }
  const unsigned char* U = p.tab + (size_t)(layer * 2) * 16384 * 1024;
  const unsigned char* V = U + (size_t)16384 * 1024;
  const float* su = p.tsc + (size_t)(layer * 2) * 16384; const float* sv_ = su + 16384;
  const float* g = p.ln_ffn_g + layer * 2048; const float* bta = p.ln_ffn_b + layer * 2048;
  for (int t = blockIdx.x * 8 + w; t < T_; t += gridDim.x * 8) {
    f32x2 hv[16], acc[16];
#pragma unroll
    for (int c = 0; c < 8; ++c) {
      float4 a = *(const float4*)(p.hf + (size_t)t * 2048 + c * 256 + lane * 4);
      hv[c * 2] = (f32x2){a.x, a.y}; hv[c * 2 + 1] = (f32x2){a.z, a.w};
      acc[c * 2] = (f32x2){0.f, 0.f}; acc[c * 2 + 1] = (f32x2){0.f, 0.f};
    }
#pragma unroll 1
    for (int hd = 0; hd < 8; ++hd) {
      const size_t so = ((size_t)t * 8 + hd) * 32;
      float cand = -3.0e38f; int eid = 0;
      if (valid) { cand = p.sv[so + ci] + p.sv[so + 16 + cj]; eid = p.si[so + ci] * 128 + p.si[so + 16 + cj]; }
      int rank = 0;
#pragma unroll
      for (int k = 0; k < 50; ++k) { const float o = __int_as_float(__builtin_amdgcn_readlane(__float_as_int(cand), k)); rank += (o > cand || (o == cand && k < lane)) ? 1 : 0; }
      const float mx = __int_as_float(__builtin_amdgcn_readlane(__float_as_int(cand), 0));
      const bool win = valid && rank < 16;
      const float e = win ? __expf(cand - mx) : 0.f;
      const float gsum = wave_sum(e);
      if (win) { we[rank] = eid; wg[rank] = e / gsum; }
      WAVE_FENCE();
      uint4 ra4[4], rb4[4]; uint2 ra2[4], rb2[4];
      PEER_LOAD(ra4, ra2, U, 0); PEER_LOAD(rb4, rb2, U, 4);
      float scu = 0.f, scv = 0.f;
      if (lane < 16) { const int e_ = we[lane]; scu = su[e_]; scv = sv_[e_]; }
      PEER_DOT(ra4, ra2, 0); PEER_LOAD(ra4, ra2, U, 8);
      PEER_DOT(rb4, rb2, 4); PEER_LOAD(rb4, rb2, U, 12);
      PEER_DOT(ra4, ra2, 8); PEER_LOAD(ra4, ra2, V, 0);
      PEER_DOT(rb4, rb2, 12); PEER_LOAD(rb4, rb2, V, 4);
      WAVE_FENCE();
      if (lane < 16) { const float a = wk[lane] * scu; wk[lane] = wg[lane] * 0.5f * a * (1.f + erff(a * 0.7071067811865476f)) * scv; }
      WAVE_FENCE();
      PEER_ACC(ra4, ra2, 0); PEER_LOAD(ra4, ra2, V, 8);
      PEER_ACC(rb4, rb2, 4); PEER_LOAD(rb4, rb2, V, 12);
      PEER_ACC(ra4, ra2, 8);
      PEER_ACC(rb4, rb2, 12);
      WAVE_FENCE();
    }
    float sm = 0.f;
#pragma unroll
    for (int i = 0; i < 16; ++i) { acc[i] += DN_ALPHA * hv[i]; sm += acc[i].x + acc[i].y; }
    const float mu = wave_sum(sm) * (1.f / 2048.f);
    float q = 0.f;
#pragma unroll
    for (int i = 0; i < 16; ++i) { float d0 = acc[i].x - mu, d1 = acc[i].y - mu; q += d0 * d0 + d1 * d1; }
    const float rstd = rsqrtf(wave_sum(q) * (1.f / 2048.f) + LN_EPS);
#pragma unroll
    for (int c = 0; c < 8; ++c) {
      const int o = c * 256 + lane * 4;
      float4 g0 = *(const float4*)(g + o), b0 = *(const float4*)(bta + o), r0;
      r0.x = (acc[c * 2].x - mu) * rstd * g0.x + b0.x; r0.y = (acc[c * 2].y - mu) * rstd * g0.y + b0.y;
      r0.z = (acc[c * 2 + 1].x - mu) * rstd * g0.z + b0.z; r0.w = (acc[c * 2 + 1].y - mu) * rstd * g0.w + b0.w;
      *(float4*)((last ? p.out : p.hf) + (size_t)t * 2048 + o) = r0;
      if (!last) { uint2 h; h.x = pack2(r0.x, r0.y); h.y = pack2(r0.z, r0.w); *(uint2*)(p.hbf + (size_t)t * 2048 + o) = h; }
    }
  }
}

#ifdef DBG
#define TOKB ((size_t)((blockIdx.x * 1031 + 5000) % 16384))
#define DMAX(idx, v) atomicMax((int*)&dbg[idx], __float_as_int(v))
DEV float blk_sum(float v, float* red) {
  v = wave_sum(v); __syncthreads(); if ((threadIdx.x & 63) == 0) red[threadIdx.x >> 6] = v; __syncthreads();
  float r = 0.f; for (int i = 0; i < 8; ++i) r += red[i]; return r;
}
DEV float blk_max(float v, float* red) {
  v = wave_max(v); __syncthreads(); if ((threadIdx.x & 63) == 0) red[threadIdx.x >> 6] = v; __syncthreads();
  float r = -3e38f; for (int i = 0; i < 8; ++i) r = fmaxf(r, red[i]); return r;
}
__global__ void __launch_bounds__(512) dbg_attn(Params p, float* dbg) {
  __shared__ float qs[128], a[2048], red[8], o_s[128];
  const size_t t = TOKB; const int tid = threadIdx.x, b = (int)(t >> 11), hh = (5 + 5 * blockIdx.x) % 12, bh = b * 12 + hh;
  float la = 0.f, lc = 0.f; for (int i = 0; i < 64; ++i) { la += p.attn_lam[i] * p.attn_lam[64 + i]; lc += p.attn_lam[128 + i] * p.attn_lam[192 + i]; }
  const float lam = expf(la) - expf(lc) + 0.2f;
  if (tid < 128) qs[tid] = bf2f(p.proj[t * PLD + hh * 128 + tid]);
  __syncthreads();
  float s1[4], s2[4], m1 = -3e38f, m2 = -3e38f;
  for (int i = 0; i < 4; ++i) {
    int key = tid + 512 * i; const bf16* kp = p.proj + ((size_t)b * 2048 + key) * PLD + 1536 + hh * 128;
    float x = 0.f, y = 0.f; for (int d = 0; d < 64; ++d) { x += qs[d] * bf2f(kp[d]); y += qs[64 + d] * bf2f(kp[64 + d]); }
    s1[i] = x; s2[i] = y; m1 = fmaxf(m1, x); m2 = fmaxf(m2, y);
  }
  m1 = blk_max(m1, red); m2 = blk_max(m2, red);
  float l1 = 0.f, l2 = 0.f; for (int i = 0; i < 4; ++i) { s1[i] = expf(s1[i] - m1); s2[i] = expf(s2[i] - m2); l1 += s1[i]; l2 += s2[i]; }
  l1 = blk_sum(l1, red); l2 = blk_sum(l2, red);
  for (int i = 0; i < 4; ++i) a[tid + 512 * i] = s1[i] / l1 - lam * s2[i] / l2;
  __syncthreads();
  float o = 0.f;
  if (tid < 128) { const bf16* vp = p.Vt + ((size_t)bh * 128 + tid) * 2048; for (int k = 0; k < 2048; ++k) o += a[k] * bf2f(vp[k]); }
  float ss = blk_sum(tid < 128 ? o * o : 0.f, red);
  float rn = rsqrtf(ss / 128.f + LN_EPS) * 0.8f;
  float err = 0.f, mag = 0.f;
  if (tid < 128) { float e = o * rn * p.attn_hn[hh * 128 + tid]; float g = bf2f(p.hbf[t * 2048 + hh * 128 + tid]); err = fabsf(e - g); mag = fabsf(e); }
  err = blk_max(err, red); mag = blk_max(mag, red);
  if (tid == 0) DMAX(2, err / (mag + 1e-6f));
}
__global__ void __launch_bounds__(512) dbg_topk(Params p, float* dbg, int layer, int idx) {
  __shared__ float qry[128], sc[128];
  const int tid = threadIdx.x; const size_t t = TOKB; const int h = (3 + blockIdx.x) % 8, pp = blockIdx.x & 1;
  for (int k = tid; k < 2048; k += 512) dbg[65536 + blockIdx.x * 2048 + k] = p.hf[t * 2048 + k];
  if (tid < 128) { float x = 0.f; for (int k = 0; k < 2048; ++k) x += p.hf[t * 2048 + k] * p.wq[(size_t)layer * 2048 * 2048 + (size_t)k * 2048 + h * 256 + pp * 128 + tid]; qry[tid] = x; }
  __syncthreads();
  if (tid < 128) { float x = 0.f; const float* sk = p.subk + ((size_t)((layer * 8 + h) * 2 + pp) * 128 + tid) * 128; for (int s = 0; s < 128; ++s) x += qry[s] * sk[s]; sc[tid] = x; }
  __syncthreads();
  if (tid == 0) {
    float err = 0.f; unsigned taken[4] = {0, 0, 0, 0};
    const size_t o = (t * 8 + h) * 32 + pp * 16;
    for (int r = 0; r < 16; ++r) {
      float best = -3e38f; int bi = 0;
      for (int n = 0; n < 128; ++n) if (!((taken[n >> 5] >> (n & 31)) & 1) && sc[n] > best) { best = sc[n]; bi = n; }
      taken[bi >> 5] |= 1u << (bi & 31);
      err = fmaxf(err, fabsf(p.sv[o + r] - best));
      int mi = p.si[o + r]; if (mi < 0 || mi > 127) err = 100.f; else err = fmaxf(err, fabsf(sc[mi] - p.sv[o + r]));
    }
    DMAX(idx, err);
  }
}
__global__ void __launch_bounds__(512) dbg_peer(Params p, float* dbg, int layer, int idx) {
  __shared__ int el[128]; __shared__ float gl[128], wl[128], red[8];
  const int tid = threadIdx.x, lane = tid & 63, w = tid >> 6; const size_t t = TOKB; const float* hrow = dbg + 65536 + blockIdx.x * 2048;
  if (tid < 8) {
    const int h = tid; const size_t o = (t * 8 + h) * 32; bool tk[256];
    float tv[16]; int te[16];
    unsigned taken[8] = {0,0,0,0,0,0,0,0};
    for (int r = 0; r < 16; ++r) {
      float best = -3e38f; int bi = 0;
      for (int c = 0; c < 256; ++c) { float v = p.sv[o + (c >> 4)] + p.sv[o + 16 + (c & 15)]; if (!((taken[c >> 5] >> (c & 31)) & 1) && v > best) { best = v; bi = c; } }
      taken[bi >> 5] |= 1u << (bi & 31);
      gl[h * 16 + r] = best; el[h * 16 + r] = p.si[o + (bi >> 4)] * 128 + p.si[o + 16 + (bi & 15)];
    }
    float mx = gl[h * 16], sm = 0.f; for (int r = 0; r < 16; ++r) sm += expf(gl[h * 16 + r] - mx);
    for (int r = 0; r < 16; ++r) gl[h * 16 + r] = expf(gl[h * 16 + r] - mx) / sm;
  }
  __syncthreads();
  for (int i = 0; i < 16; ++i) {
    int ix = w * 16 + i; const float* up = p.pu + (size_t)layer * 16384 * 2048 + (size_t)el[ix] * 2048; float x = 0.f;
    for (int k = lane; k < 2048; k += 64) x += hrow[k] * up[k];
    x = wave_sum(x);
    if (lane == 0) wl[ix] = gl[ix] * 0.5f * x * (1.f + erff(x * 0.7071067811865476f));
  }
  __syncthreads();
  float z[4], s = 0.f;
  for (int j = 0; j < 4; ++j) { int d = tid * 4 + j; float f = 0.f; for (int i = 0; i < 128; ++i) f += wl[i] * p.pv[(size_t)layer * 16384 * 2048 + (size_t)el[i] * 2048 + d]; z[j] = DN_ALPHA * hrow[d] + f; s += z[j]; }
  float mu = blk_sum(s, red) / 2048.f; float q = 0.f; for (int j = 0; j < 4; ++j) q += (z[j] - mu) * (z[j] - mu);
  float rstd = rsqrtf(blk_sum(q, red) / 2048.f + LN_EPS);
  float err = 0.f;
  for (int j = 0; j < 4; ++j) { int d = tid * 4 + j; float e = (z[j] - mu) * rstd * p.ln_ffn_g[layer * 2048 + d] + p.ln_ffn_b[layer * 2048 + d]; err = fmaxf(err, fabsf(e - (layer ? p.out : p.hf)[t * 2048 + d])); }
  err = blk_max(err, red);
  if (tid == 0) DMAX(idx, err);
}
__global__ void __launch_bounds__(512) dbg_mlstm(Params p, float* dbg) {
  __shared__ float numl[132], red[8];
  const int k_ = blockIdx.x, tid = threadIdx.x, b = (2 + k_) % 8, hh = (5 + 5 * k_) % 12, c_ = (2 + 3 * k_) % 16, lo = c_ * 128, hi = lo + 127, bh = b * 12 + hh, kd = tid >> 2, vd0 = (tid & 3) * 32;
  for (int dir = 0; dir < 2; ++dir) {
    float C[32]; for (int e = 0; e < 32; ++e) C[e] = 0.f; float n = 0.f, m = 0.f, err = 0.f, mag = 0.f;
    const float* dump = p.mst + 4096 + k_ * 32768 + dir * 16384;
    for (int sp = 0; sp < 2048; ++sp) {
      const int s = dir ? 2047 - sp : sp; if (dir == 0 ? (s > hi) : (s < lo)) break;
      const size_t t = (size_t)b * 2048 + s;
      const float ig = p.gates[t * 48 + (2 * dir) * 12 + hh] + p.ml_gb[(2 * dir) * 12 + hh];
      const float lf = log_sigmoid(p.gates[t * 48 + (2 * dir + 1) * 12 + hh] + p.ml_gb[(2 * dir + 1) * 12 + hh]);
      const float mn = fmaxf(lf + m, ig), dec = expf(lf + m - mn), wv = expf(ig - mn); m = mn;
      const float kk = bf2f(p.proj[t * PLD + 1536 + hh * 128 + kd]);
      for (int e = 0; e < 32; ++e) C[e] = dec * C[e] + wv * kk * bf2f(p.Vt[((size_t)bh * 128 + vd0 + e) * 2048 + s]);
      n = dec * n + wv * kk;
      if (s >= lo && s <= hi) {
        const float q = bf2f(p.proj[t * PLD + hh * 128 + kd]);
        __syncthreads(); if (tid < 132) numl[tid] = 0.f; __syncthreads();
        for (int e = 0; e < 32; ++e) atomicAdd(&numl[vd0 + e], q * C[e]);
        if ((tid & 3) == 0) atomicAdd(&numl[128], q * n);
        __syncthreads();
        if (tid < 128) { float h = numl[tid] / fmaxf(fabsf(numl[128]), expf(-m)); float g = dump[(s - lo) * 128 + tid]; err += fabsf(h - g); mag += fabsf(h); }
      }
    }
    err = blk_sum(err, red); mag = blk_sum(mag, red);
    if (tid == 0) { DMAX(dir, err / (mag + 1e-6f)); dbg[40 + dir * 8 + k_] = err / (mag + 1e-6f); }
  }
}

DEV float blk_dotf(const float* row, const float* W, int ldw, int col, float* red) {
  float x = 0.f; for (int k = threadIdx.x; k < 2048; k += 512) x += row[k] * W[(size_t)k * ldw + col];
  return blk_sum(x, red);
}
DEV void chk(float* dbg, int idx, float got, float exp) { if (threadIdx.x == 0) { float e = fabsf(got - exp) / (0.02f + 0.02f * fabsf(exp)); DMAX(idx, e); } }
__global__ void __launch_bounds__(512) dbg_proj0(Params p, float* dbg) {
  __shared__ float red[8];
  const size_t t = TOKB; const float* xr = p.x + t * 2048; const int b_ = (int)(t >> 11), s_ = (int)(t & 2047);
  const float inv = powf(10000.f, -9.f / 32.f); const float ang = (float)p.pos[t] * inv; const float cs = cosf(ang), sn = sinf(ang);
  { float a = blk_dotf(xr, p.attn_w, 5120, 457, red), b = blk_dotf(xr, p.attn_w, 5120, 489, red);
    chk(dbg, 8, bf2f(p.proj[t * PLD + 457]), (a * cs - b * sn) * 0.125f); chk(dbg, 8, bf2f(p.proj[t * PLD + 489]), (b * cs + a * sn) * 0.125f); }
  { float a = blk_dotf(xr, p.attn_w, 5120, 1536 + 457, red), b = blk_dotf(xr, p.attn_w, 5120, 1536 + 489, red);
    chk(dbg, 9, bf2f(p.proj[t * PLD + 1536 + 457]), (a * cs - b * sn)); chk(dbg, 9, bf2f(p.proj[t * PLD + 1536 + 489]), (b * cs + a * sn)); }
  { float a = blk_dotf(xr, p.attn_w, 5120, 3072 + 700, red); chk(dbg, 10, bf2f(p.Vt[((size_t)(b_ * 12 + 5) * 128 + 60) * 2048 + s_]), a); }
  { float a = blk_dotf(xr, p.attn_w, 5120, 4608 + 300, red); chk(dbg, 11, bf2f(p.proj[t * PLD + 3072 + 300]), a * 0.08838834764831845f); }
  { const int r_ = (700 + blockIdx.x * 263) % 2048; const float* mr = p.mem + (size_t)r_ * 2048; float a = blk_dotf(mr, p.memkv_w, 1024, 300, red), b = blk_dotf(mr, p.memkv_w, 1024, 812, red);
    chk(dbg, 12, bf2f(p.memK[(size_t)r_ * 512 + 300]), a); chk(dbg, 12, bf2f(p.memVt[((size_t)((r_ >> 8) * 4 + 2) * 128 + 44) * 256 + (r_ & 255)]), b); }
}
__global__ void __launch_bounds__(512) dbg_memattn(Params p, float* dbg, int qmcol, int idx) {
  __shared__ float qs[128], a[256], red[8];
  const size_t t = TOKB; const int tid = threadIdx.x, b = (int)(t >> 11), mh = blockIdx.x & 3;
  if (tid < 128) qs[tid] = bf2f(p.proj[t * PLD + qmcol + mh * 128 + tid]);
  __syncthreads();
  float sc = -3e38f;
  if (tid < 256) { sc = 0.f; const bf16* kp = p.memK + ((size_t)b * 256 + tid) * 512 + mh * 128; for (int d = 0; d < 128; ++d) sc += qs[d] * bf2f(kp[d]); }
  float mx = blk_max(sc, red); float e = tid < 256 ? expf(sc - mx) : 0.f; float l = blk_sum(e, red);
  if (tid < 256) a[tid] = e / l;
  __syncthreads();
  if (tid < 128) { float o = 0.f; const bf16* vp = p.memVt + ((size_t)(b * 4 + mh) * 128 + tid) * 256; for (int k = 0; k < 256; ++k) o += a[k] * bf2f(vp[k]);
    float g = bf2f(p.hbf[t * 2048 + 1536 + mh * 128 + tid]); float er = fabsf(g - o) / (0.01f + 0.03f * fabsf(o)); atomicMax((int*)&dbg[idx], __float_as_int(er)); }
}
__global__ void __launch_bounds__(512) dbg_z(Params p, float* dbg, int layer, int idx) {
  __shared__ float cr[2048];
  const int tid = threadIdx.x; const size_t t = TOKB;
  for (int k = tid; k < 2048; k += 512) cr[k] = bf2f(p.hbf[t * 2048 + k]);
  __syncthreads();
  const float* hp = layer == 0 ? p.x + t * 2048 : dbg + 131072 + blockIdx.x * 2048;
  const float* W = p.w_out + (size_t)layer * 2048 * 2048;
  for (int j = 0; j < 4; ++j) { int n = tid + 512 * j; float y = 0.f; for (int k = 0; k < 2048; ++k) y += cr[k] * W[(size_t)k * 2048 + n];
    float z = DN_ALPHA * hp[n] + y; dbg[32768 + blockIdx.x * 2048 + n] = z; float er = fabsf(p.hf[t * 2048 + n] - z) / (0.02f + 0.02f * fabsf(z)); atomicMax((int*)&dbg[idx], __float_as_int(er)); }
}
__global__ void __launch_bounds__(512) dbg_ln(Params p, float* dbg, int layer, int idx) {
  __shared__ float red[8];
  const int tid = threadIdx.x; const size_t t = TOKB; const float* z = dbg + 32768 + blockIdx.x * 2048;
  float s = 0.f; for (int j = 0; j < 4; ++j) s += z[tid + 512 * j];
  float mu = blk_sum(s, red) / 2048.f; float q = 0.f; for (int j = 0; j < 4; ++j) { float d = z[tid + 512 * j] - mu; q += d * d; }
  float rstd = rsqrtf(blk_sum(q, red) / 2048.f + LN_EPS);
  for (int j = 0; j < 4; ++j) { int n = tid + 512 * j; float e = (z[n] - mu) * rstd * p.ln_mix_g[layer * 2048 + n] + p.ln_mix_b[layer * 2048 + n];
    float er = fabsf(p.hf[t * 2048 + n] - e) / (0.02f + 0.02f * fabsf(e)); atomicMax((int*)&dbg[idx], __float_as_int(er));
    float er2 = fabsf(bf2f(p.hbf[t * 2048 + n]) - e) / (0.02f + 0.02f * fabsf(e)); atomicMax((int*)&dbg[idx], __float_as_int(er2)); }
}
__global__ void __launch_bounds__(512) dbg_proj1(Params p, float* dbg) {
  __shared__ float red[8];
  const size_t t = TOKB; const float* xr = p.hf + t * 2048; const int b_ = (int)(t >> 11), s_ = (int)(t & 2047);
  for (int k = threadIdx.x; k < 2048; k += 512) dbg[131072 + blockIdx.x * 2048 + k] = xr[k];
  const float sc = 0.08838834764831845f;
  { float a = blk_dotf(xr, p.ml_w, 6704, 200, red); chk(dbg, 16, bf2f(p.proj[t * PLD + 200]), a); }
  { float a = blk_dotf(xr, p.ml_w, 6704, 1536 + 200, red); chk(dbg, 16, bf2f(p.proj[t * PLD + 1536 + 200]), a * sc); }
  { float a = blk_dotf(xr, p.ml_w, 6704, 4608 + 200, red); chk(dbg, 16, bf2f(p.proj[t * PLD + 3072 + 200]), a); }
  { float a = blk_dotf(xr, p.ml_w, 6704, 6144 + 200, red); chk(dbg, 16, bf2f(p.proj[t * PLD + 4608 + 200]), a * sc); }
  { float a = blk_dotf(xr, p.ml_w, 6704, 6656 + 7, red); chk(dbg, 17, p.gates[t * 48 + 7], a); }
  { float a = blk_dotf(xr, p.ml_w, 6704, 6656 + 40, red); chk(dbg, 17, p.gates[t * 48 + 40], a); }
  { float a = blk_dotf(xr, p.ml_w, 6704, 3072 + 700, red); chk(dbg, 17, bf2f(p.Vt[((size_t)(b_ * 12 + 5) * 128 + 60) * 2048 + s_]), a); }
}
__global__ void __launch_bounds__(128) dbg_mlcomb(Params p, float* dbg) {
  __shared__ float red[8];
  const int k_ = blockIdx.x, tid = threadIdx.x, j = (37 + 11 * k_) & 127, hh = (5 + 5 * k_) % 12; const size_t t = (size_t)((2 + k_) % 8) * 2048 + ((2 + 3 * k_) % 16) * 128 + j;
  float h = p.mst[4096 + k_ * 32768 + j * 128 + tid] + p.mst[4096 + k_ * 32768 + 16384 + j * 128 + tid];
  float v = wave_sum(h * h); __syncthreads(); if ((tid & 63) == 0) red[tid >> 6] = v; __syncthreads();
  float rn = rsqrtf((red[0] + red[1]) / 128.f + LN_EPS);
  float o = bf2f(p.proj[t * PLD + 3072 + hh * 128 + tid]);
  float e = h * rn * p.ml_hn[hh * 128 + tid] / (1.f + expf(-o));
  float er = fabsf(bf2f(p.hbf[t * 2048 + hh * 128 + tid]) - e) / (0.02f + 0.02f * fabsf(e)); atomicMax((int*)&dbg[18], __float_as_int(er));
}
__global__ void dbg_init(float* dbg) { if (threadIdx.x < 64) dbg[threadIdx.x] = 0.f; }
__global__ void dbg_final(Params p, float* dbg) {
  const int order[21] = {8, 9, 10, 11, 12, 13, 2, 14, 15, 3, 4, 16, 17, 0, 1, 18, 19, 20, 21, 22, 23};
  const float thr[21] = {1, 1, 1, 1, 1, 1, 0.05f, 1, 1, 0.05f, 0.05f, 1, 1, 0.1f, 0.1f, 1, 1, 1, 1, 0.05f, 0.05f};
  int code = 0;
  for (int i = 20; i >= 0; --i) if (!(dbg[order[i]] < thr[i])) code = i + 1;
  if (code == 14 || code == 15) {
    int wk = 0; float we = -1.f;
    for (int i = 0; i < 16; ++i) if (dbg[40 + i] > we) { we = dbg[40 + i]; wk = i; }
    int cls = we < 0.2f ? 0 : we < 0.5f ? 1 : we < 1.0f ? 2 : we < 2.f ? 3 : 4;
    code = wk * 5 + cls;
  }
  p.out[0] = 1000.f * (10 + code);
}
#endif

#define XB_TMO      128
#define XB_XCNT(j)  (256  + 64 * (j))
#define XB_XSUB(j)  (1280 + 64 * (j))
#define XB_XGEN(j)  (2304 + 64 * (j))
#define XB_TOP      3328
#define XB_TOPGEN   3392
#define XCD_BAR_WORDS 3456
#define XB_SPIN_CAP (1u << 21)
#define LAS __attribute__((address_space(3)))

__device__ __forceinline__ unsigned xb_ld(unsigned* p)              { return __hip_atomic_load(p, __ATOMIC_RELAXED, __HIP_MEMORY_SCOPE_AGENT); }
__device__ __forceinline__ unsigned xb_add(unsigned* p, unsigned v) { return __hip_atomic_fetch_add(p, v, __ATOMIC_RELAXED, __HIP_MEMORY_SCOPE_AGENT); }
__device__ __forceinline__ unsigned xb_xcc_id() { return (unsigned)__builtin_amdgcn_s_getreg((3 << 11) | 20) & 0xFu; }
#define XB_SPIN(cond, bar) do { unsigned _sp = 0; while (cond) { __builtin_amdgcn_s_sleep(1); \
    if ((++_sp & 255u) == 0u) { if (xb_ld(&(bar)[XB_TMO])) break; if (_sp > XB_SPIN_CAP) { atomicAdd(&(bar)[XB_TMO], 1u); break; } } } } while (0)

struct XcdBarrier {
    unsigned* bar; unsigned x;
    volatile LAS unsigned* st;
};

__device__ __forceinline__ XcdBarrier xcd_barrier_post(unsigned* bar, volatile LAS unsigned* st) {
    XcdBarrier b; b.bar = bar; b.x = xb_xcc_id(); b.st = st;
    if (threadIdx.x == 0) (void)xb_add(&bar[XB_XCNT(b.x)], 1u);
    return b;
}
__device__ __forceinline__ void xcd_barrier_complete(unsigned* bar, unsigned x, unsigned& nloc, unsigned& nx) {
    const unsigned G = gridDim.x * gridDim.y * gridDim.z;
    unsigned sum, cnt, mine, sp = 0u;
    for (;;) {
        sum = 0u; cnt = 0u; mine = 0u;
#pragma unroll
        for (unsigned j = 0; j < 16; ++j) { const unsigned c = xb_ld(&bar[XB_XCNT(j)]); sum += c; cnt += (c > 0u) ? 1u : 0u; mine = (j == x) ? c : mine; }
        if (sum == G) break;
        __builtin_amdgcn_s_sleep(1);
        if ((++sp & 255u) == 0u) { if (xb_ld(&bar[XB_TMO])) break; if (sp > XB_SPIN_CAP) { atomicAdd(&bar[XB_TMO], 1u); break; } }
    }
    nloc = mine > 0u ? mine : 1u; nx = cnt > 0u ? cnt : 1u;
}

__device__ __forceinline__ void xcd_barrier(const XcdBarrier& b) {
    asm volatile("s_waitcnt vmcnt(0)" ::: "memory");
    __syncthreads();
    if (threadIdx.x == 0) {
        unsigned* bar = b.bar;
        __builtin_amdgcn_s_waitcnt(0);
        unsigned nloc = b.st[0], nx = b.st[1];
        if (nloc == 0u) { xcd_barrier_complete(bar, b.x, nloc, nx); b.st[0] = nloc; b.st[1] = nx; }
        const unsigned old = xb_add(&bar[XB_XSUB(b.x)], 1u);
        const unsigned gen = old / nloc;
        if (old + 1u == (gen + 1u) * nloc) {
            __builtin_amdgcn_fence(__ATOMIC_RELEASE, "agent");
            asm volatile("s_waitcnt vmcnt(0)" ::: "memory");
            const unsigned og = xb_add(&bar[XB_TOP], 1u);
            const unsigned tg = og / nx;
            if (og + 1u == (tg + 1u) * nx) xb_add(&bar[XB_TOPGEN], 1u);
            else XB_SPIN(xb_ld(&bar[XB_TOPGEN]) == tg, bar);
            __builtin_amdgcn_fence(__ATOMIC_ACQUIRE, "agent");
            xb_add(&bar[XB_XGEN(b.x)], 1u);
            asm volatile("s_waitcnt vmcnt(0)" ::: "memory");
        } else {
            XB_SPIN(xb_ld(&bar[XB_XGEN(b.x)]) == gen, bar);
            __builtin_amdgcn_fence(__ATOMIC_ACQUIRE, "agent");
            asm volatile("s_waitcnt vmcnt(0)" ::: "memory");
        }
    }
    __syncthreads();
}


__global__ void __launch_bounds__(NT) mega(Params p) {
  extern __shared__ __attribute__((aligned(16))) char smem[];
  cg::grid_group grid = cg::this_grid();
  __shared__ uint4 xb_words;
  if (threadIdx.x == 0) xb_words = make_uint4(0u, 0u, 0u, 0u);
  __syncthreads();
  XcdBarrier xb = xcd_barrier_post(p.bar, (volatile LAS unsigned*)&xb_words);
#ifndef PH_MASK
#define PH_MASK 0x7fff
#endif
#ifndef DUP_MASK
#define DUP_MASK 0
#endif
#define RUNPH(n, ...) if constexpr ((PH_MASK >> n) & 1) { if (p.ph_lo <= n && n < p.ph_hi) { __VA_ARGS__; if constexpr ((DUP_MASK >> n) & 1) { __VA_ARGS__; } if (n + 1 < p.ph_hi) { if (n == 0) grid.sync(); else xcd_barrier(xb); } } }
  RUNPH(0, phase_convert(p, smem))
  RUNPH(1, phase_gemm2<EPI_ATTN>(p, p.hbf, p.WtAttn, 64, 20, 0, smem, 0, 1280); phase_gemm<EPI_MEMKV>(p, p.membf, p.WtMemkv, 16, 4, 0, smem, 1280, 1280 + 64))
  RUNPH(2, phase_attn0(p, smem))
  RUNPH(3, phase_gemm2<EPI_OUT>(p, p.hbf, p.WtOut, 64, 8, 0, smem, 0, 512))
  RUNPH(4, phase_ln(p, p.ln_mix_g, p.ln_mix_b, p.x))
  RUNPH(5, phase_gemm<EPI_PEERQ>(p, p.hbf, p.WtQ, 128, 8, 0, smem, 0, 1024))
  RUNPH(6, phase_peer(p, 0, smem, false))
  RUNPH(7, phase_gemm2<EPI_ML>(p, p.hbf, p.WtMl, 64, 27, 1, smem, 0, 64 * 27))
  RUNPH(8, for (int it = blockIdx.x; it < 3072; it += gridDim.x) ml_summary_item(p, it, smem))
  RUNPH(9, for (int it = blockIdx.x; it < 768; it += gridDim.x) ml_scan_item(p, it))
  RUNPH(10, for (int it = blockIdx.x; it < 1536; it += gridDim.x) ml_out_item(p, it, smem); for (int it = blockIdx.x; it < 256; it += gridDim.x) mem_attn_item(p, it, 4608, smem))
  RUNPH(11, phase_gemm2<EPI_OUT>(p, p.hbf, p.WtOut + (size_t)2048 * 2048, 64, 8, 1, smem, 0, 512))
  RUNPH(12, phase_ln(p, p.ln_mix_g + 2048, p.ln_mix_b + 2048, p.hf))
  RUNPH(13, phase_gemm<EPI_PEERQ>(p, p.hbf, p.WtQ + (size_t)2048 * 2048, 128, 8, 1, smem, 0, 1024))
  RUNPH(14, phase_peer(p, 1, smem, true))
}

#ifndef MULTI_LAUNCH
#define MULTI_LAUNCH 0
#endif

extern "C" void kernel_launch(void* const* d_in, const int* in_sizes, int n_in, void* d_out, int out_size, void* d_ws, size_t ws_size, hipStream_t stream) {
  static int grid_blocks = 0;
  if (!grid_blocks) {
    int dev = 0, cus = 0, per_cu = 0;
    hipGetDevice(&dev);
    hipDeviceGetAttribute(&cus, hipDeviceAttributeMultiprocessorCount, dev);
    hipFuncSetAttribute((const void*)mega, hipFuncAttributeMaxDynamicSharedMemorySize, (int)LDS_BYTES);
    hipOccupancyMaxActiveBlocksPerMultiprocessor(&per_cu, mega, NT, LDS_BYTES);
    if (per_cu < 1) per_cu = 1;
    grid_blocks = cus * per_cu;
  }
  Params p{};
  p.x = (const float*)d_in[0]; p.mem = (const float*)d_in[1]; p.pos = (const int*)d_in[2];
  p.attn_w = (const float*)d_in[3]; p.attn_lam = (const float*)d_in[4]; p.attn_hn = (const float*)d_in[5];
  p.ml_w = (const float*)d_in[6]; p.ml_gb = (const float*)d_in[7]; p.ml_hn = (const float*)d_in[8];
  p.memkv_w = (const float*)d_in[9]; p.w_out = (const float*)d_in[10]; p.ln_mix_g = (const float*)d_in[11]; p.ln_mix_b = (const float*)d_in[12];
  p.wq = (const float*)d_in[13]; p.subk = (const float*)d_in[14]; p.pu = (const float*)d_in[15]; p.pv = (const float*)d_in[16];
  p.ln_ffn_g = (const float*)d_in[17]; p.ln_ffn_b = (const float*)d_in[18];
  p.out = (float*)d_out;
  char* w = (char*)d_ws; size_t off = 0;
  auto take = [&](size_t bytes) { char* r = w + off; off += (bytes + 255) & ~(size_t)255; return r; };
  p.tab = (unsigned char*)take((size_t)4 * 16384 * 1536);
  p.tsc = (float*)take((size_t)4 * 16384 * 4);
  p.ybf = (bf16*)take((size_t)T_ * 2048 * 2);
  p.WtAttn = (bf16*)take((size_t)5120 * 2048 * 2);
  p.WtMl = (bf16*)take((size_t)NMLPAD * 2048 * 2);
  p.WtMemkv = (bf16*)take((size_t)1024 * 2048 * 2);
  p.WtOut = (bf16*)take((size_t)2 * 2048 * 2048 * 2);
  p.WtQ = (bf16*)take((size_t)2 * 2048 * 2048 * 2);
  p.SK = (bf16*)take((size_t)524288 * 2);
  p.membf = (bf16*)take((size_t)2048 * 2048 * 2);
  p.hbf = (bf16*)take((size_t)T_ * 2048 * 2);
  p.proj = (bf16*)take((size_t)T_ * PLD * 2);
  p.Vt = (bf16*)take((size_t)B_ * 12 * 128 * 2048 * 2);
  p.memK = (bf16*)take((size_t)2048 * 512 * 2);
  p.memVt = (bf16*)take((size_t)B_ * 4 * 128 * 256 * 2);
  p.hf = (float*)take((size_t)T_ * 2048 * 4);
  p.gates = (float*)take((size_t)T_ * 48 * 4);
  p.sv = (float*)take((size_t)T_ * 256 * 4);
  p.si = (int*)take((size_t)T_ * 256 * 4);
  p.kvT = (bf16*)take((size_t)3072 * 16384 * 2);
  p.nvec = (float*)take((size_t)3072 * 128 * 4);
  p.scal = (float*)take((size_t)3072 * 2 * 4);
  p.bar = (unsigned*)take((size_t)XCD_BAR_WORDS * 4);
  p.mst = (float*)take((size_t)3072 * 4 + 4000000);
  if (off > ws_size) { fprintf(stderr, "workspace too small: need %zu have %zu\n", off, ws_size); return; }
#if MULTI_LAUNCH
  for (int ph = 0; ph < NPHASE; ++ph) {
    p.ph_lo = ph; p.ph_hi = ph + 1;
    hipLaunchKernelGGL(mega, dim3(grid_blocks), dim3(NT), LDS_BYTES, stream, p);
#ifdef DBG
    float* dbg = p.mst + 300000;
    if (ph == 0) hipLaunchKernelGGL(dbg_init, dim3(1), dim3(64), 0, stream, dbg);
    if (ph == 1) hipLaunchKernelGGL(dbg_proj0, dim3(8), dim3(512), 0, stream, p, dbg);
    if (ph == 2) { hipLaunchKernelGGL(dbg_attn, dim3(8), dim3(512), 0, stream, p, dbg); hipLaunchKernelGGL(dbg_memattn, dim3(8), dim3(512), 0, stream, p, dbg, 3072, 13); }
    if (ph == 3) hipLaunchKernelGGL(dbg_z, dim3(8), dim3(512), 0, stream, p, dbg, 0, 14);
    if (ph == 4) hipLaunchKernelGGL(dbg_ln, dim3(8), dim3(512), 0, stream, p, dbg, 0, 15);
    if (ph == 5) hipLaunchKernelGGL(dbg_topk, dim3(8), dim3(512), 0, stream, p, dbg, 0, 3);
    if (ph == 6) hipLaunchKernelGGL(dbg_peer, dim3(8), dim3(512), 0, stream, p, dbg, 0, 4);
    if (ph == 7) hipLaunchKernelGGL(dbg_proj1, dim3(8), dim3(512), 0, stream, p, dbg);
    if (ph == 10) { hipLaunchKernelGGL(dbg_mlstm, dim3(8), dim3(512), 0, stream, p, dbg); hipLaunchKernelGGL(dbg_mlcomb, dim3(8), dim3(128), 0, stream, p, dbg); hipLaunchKernelGGL(dbg_memattn, dim3(8), dim3(512), 0, stream, p, dbg, 4608, 19); }
    if (ph == 11) hipLaunchKernelGGL(dbg_z, dim3(8), dim3(512), 0, stream, p, dbg, 1, 20);
    if (ph == 12) hipLaunchKernelGGL(dbg_ln, dim3(8), dim3(512), 0, stream, p, dbg, 1, 21);
    if (ph == 13) hipLaunchKernelGGL(dbg_topk, dim3(8), dim3(512), 0, stream, p, dbg, 1, 22);
    if (ph == 14) hipLaunchKernelGGL(dbg_peer, dim3(8), dim3(512), 0, stream, p, dbg, 1, 23);
    if (ph == 14) hipLaunchKernelGGL(dbg_final, dim3(1), dim3(1), 0, stream, p, dbg);
#endif
  }
#else
  p.ph_lo = 0; p.ph_hi = NPHASE;
  hipMemsetAsync(p.bar, 0, (size_t)XCD_BAR_WORDS * 4, stream);
  void* args[] = {&p};
  hipError_t e = hipLaunchCooperativeKernel((void*)mega, dim3(grid_blocks), dim3(NT), args, LDS_BYTES, stream);
  if (e != hipSuccess) fprintf(stderr, "cooperative launch failed: %s (grid %d)\n", hipGetErrorString(e), grid_blocks);
#endif
}
```

```cpp
#include <hip/hip_runtime.h>
#include <hip/hip_cooperative_groups.h>
#include <cstdio>
#include <cstdint>
namespace cg = cooperative_groups;

typedef unsigned short bf16;
typedef __attribute__((ext_vector_type(8))) short bf16x8;
typedef __attribute__((ext_vector_type(16))) float f32x16;
#define DEV __device__ __forceinline__

constexpr int NT = 512;
constexpr int T_ = 16384, D_ = 2048, S_ = 2048, B_ = 8;
constexpr int PLD = 5120;
constexpr int NMLPAD = 6912;
constexpr size_t LDS_BYTES = 147456;
constexpr float DN_ALPHA = 1.4142135623730951f;
constexpr float LN_EPS = 1e-5f;
constexpr int NPHASE = 15;

struct Params {
  const float *x, *mem; const int* pos;
  const float *attn_w, *attn_lam, *attn_hn, *ml_w, *ml_gb, *ml_hn, *memkv_w, *w_out, *ln_mix_g, *ln_mix_b,
      *wq, *subk, *pu, *pv, *ln_ffn_g, *ln_ffn_b;
  float* out;
  unsigned char* tab;
  bf16* ybf;
  bf16 *WtAttn, *WtMl, *WtMemkv, *WtOut, *WtQ, *SK, *membf, *hbf, *proj, *Vt, *memK, *memVt;
  float *hf, *gates, *sv, *nvec, *scal, *mst, *tsc;
  bf16* kvT;
  int* si;
  unsigned* bar;
  int ph_lo, ph_hi;
};

DEV bf16 f2bf(float f) { uint32_t u = __float_as_uint(f); u += 0x7fffu + ((u >> 16) & 1u); return (bf16)(u >> 16); }
DEV float bf2f(bf16 h) { return __uint_as_float(((uint32_t)h) << 16); }
typedef __attribute__((ext_vector_type(2))) __bf16 bf16v2_t;
typedef __attribute__((ext_vector_type(2))) float f32v2_t;
DEV uint32_t pack2(float a, float b) { f32v2_t x = {a, b}; return __builtin_bit_cast(uint32_t, __builtin_convertvector(x, bf16v2_t)); }
DEV float bflo(uint32_t u) { return __uint_as_float(u << 16); }
DEV float bfhi(uint32_t u) { return __uint_as_float(u & 0xffff0000u); }
DEV f32x16 mfma32(bf16x8 a, bf16x8 b, f32x16 c) { return __builtin_amdgcn_mfma_f32_32x32x16_bf16(a, b, c, 0, 0, 0); }
DEV f32x16 zero16() { f32x16 z; for (int i = 0; i < 16; ++i) z[i] = 0.f; return z; }
DEV float wave_sum(float v) { for (int o = 32; o > 0; o >>= 1) v += __shfl_xor(v, o); return v; }
DEV float wave_max(float v) { for (int o = 32; o > 0; o >>= 1) v = fmaxf(v, __shfl_xor(v, o)); return v; }
DEV bf16x8 ld8(const bf16* p) { return *(const bf16x8*)p; }
typedef __attribute__((ext_vector_type(4))) uint32_t u32x4;
DEV bf16x8 mk8(uint32_t a, uint32_t b, uint32_t c, uint32_t d) {
  u32x4 t = {a, b, c, d}; return __builtin_bit_cast(bf16x8, t);
}

DEV void conv_transpose_tile(const float* __restrict__ src, int N, bf16* __restrict__ dst, int tile, char* smem) {
  float* tl = (float*)smem;
  const int nt = tile >> 5, kt = tile & 31, tid = threadIdx.x;
  __syncthreads();
  for (int ps = 0; ps < 8; ++ps) {
    int r = ps * 8 + (tid >> 6), c = tid & 63;
    int n = nt * 64 + c;
    tl[r * 65 + c] = (n < N) ? src[(size_t)(kt * 64 + r) * N + n] : 0.f;
  }
  __syncthreads();
  for (int ps = 0; ps < 8; ++ps) {
    int n = ps * 8 + (tid >> 6), k = tid & 63;
    dst[(size_t)(nt * 64 + n) * 2048 + kt * 64 + k] = f2bf(tl[k * 65 + n]);
  }
}
DEV void conv_lin(const float* __restrict__ src, bf16* __restrict__ dst, size_t item) {
  size_t o = item * 4096 + (size_t)threadIdx.x * 8;
  float4 a = *(const float4*)(src + o), b = *(const float4*)(src + o + 4);
  uint4 r; r.x = pack2(a.x, a.y); r.y = pack2(a.z, a.w); r.z = pack2(b.x, b.y); r.w = pack2(b.z, b.w);
  *(uint4*)(dst + o) = r;
}
DEV void phase_convert(const Params& p, char* smem) {
  const int nTt = 2560 + 3456 + 512 + 2048 + 2048;
  for (int it = blockIdx.x; it < nTt; it += gridDim.x) {
    int t = it;
    if (t < 2560) { conv_transpose_tile(p.attn_w, 5120, p.WtAttn, t, smem); continue; } t -= 2560;
    if (t < 3456) { conv_transpose_tile(p.ml_w, 6704, p.WtMl, t, smem); continue; } t -= 3456;
    if (t < 512) { conv_transpose_tile(p.memkv_w, 1024, p.WtMemkv, t, smem); continue; } t -= 512;
    if (t < 2048) { int l = t >> 10; conv_transpose_tile(p.w_out + (size_t)l * 2048 * 2048, 2048, p.WtOut + (size_t)l * 2048 * 2048, t & 1023, smem); continue; } t -= 2048;
    { int l = t >> 10; conv_transpose_tile(p.wq + (size_t)l * 2048 * 2048, 2048, p.WtQ + (size_t)l * 2048 * 2048, t & 1023, smem); }
  }
  for (int it = blockIdx.x; it < 8192; it += gridDim.x) {
    const int lane = threadIdx.x & 63, row = it * 8 + (threadIdx.x >> 6);
    const int tbl = row >> 14, e = row & 16383, layer = tbl >> 1, which = tbl & 1;
    const float* sp = (which ? p.pv : p.pu) + ((size_t)layer * 16384 + e) * 2048 + lane * 4;
    float x[32];
    float m = 0.f;
#pragma unroll
    for (int c = 0; c < 8; ++c) {
      float4 a = *(const float4*)(sp + c * 256);
      x[c * 4] = a.x; x[c * 4 + 1] = a.y; x[c * 4 + 2] = a.z; x[c * 4 + 3] = a.w;
      m = fmaxf(m, fmaxf(fmaxf(fabsf(a.x), fabsf(a.y)), fmaxf(fabsf(a.z), fabsf(a.w))));
    }
    m = wave_max(m);
    const float inv = m > 0.f ? 6.f / m : 0.f;
    if (lane == 0) p.tsc[row] = m > 0.f ? m * (1.f / 6.f) : 0.f;
    uint32_t wv[4] = {0u, 0u, 0u, 0u};
#pragma unroll
    for (int k = 0; k < 32; ++k) {
      const float y = x[k] * inv, a = fabsf(y);
      float c = a < 2.f ? rintf(a * 2.f) : (a < 4.f ? 4.f + rintf(a - 2.f) : fminf(7.f, 6.f + rintf((a - 4.f) * 0.5f)));
      wv[k >> 3] |= ((uint32_t)c | (y < 0.f ? 8u : 0u)) << ((k & 7) * 4);
    }
    *(uint4*)(p.tab + (size_t)row * 1024 + lane * 16) = make_uint4(wv[0], wv[1], wv[2], wv[3]);
  }
  const int nL = 128 + 1024 + 8192;
  for (int it = blockIdx.x; it < nL; it += gridDim.x) {
    int t = it;
    if (t < 128) { conv_lin(p.subk, p.SK, t); continue; } t -= 128;
    if (t < 1024) { conv_lin(p.mem, p.membf, t); continue; } t -= 1024;
    conv_lin(p.x, p.hbf, t);
  }
}

enum { EPI_ATTN = 0, EPI_ML = 1, EPI_MEMKV = 2, EPI_OUT = 3, EPI_PEERQ = 4 };

template <int EPI>
DEV void epi64(const Params& p, int layer, int cb, int rb0, int l32, int hl, const f32x16& a00, const f32x16& a01, const f32x16& a10, const f32x16& a11) {
  f32x16 acc[2][2]; acc[0][0] = a00; acc[0][1] = a01; acc[1][0] = a10; acc[1][1] = a11;
  if constexpr (EPI == EPI_ATTN || EPI == EPI_ML) {
    int cls;
    float scale = 1.f; int dcol = 0;
    if constexpr (EPI == EPI_ATTN) {
      if (cb < 1536) { cls = 0; scale = 0.125f * 1.4426950408889634f; dcol = cb; }
      else if (cb < 3072) { cls = 1; dcol = cb; }
      else if (cb < 4608) { cls = 3; dcol = cb - 3072; }
      else { cls = 2; scale = 0.08838834764831845f * 1.4426950408889634f; dcol = cb - 4608 + 3072; }
    } else {
      if (cb < 1536) { cls = 2; dcol = cb; }
      else if (cb < 3072) { cls = 2; scale = 0.08838834764831845f; dcol = cb; }
      else if (cb < 4608) { cls = 3; dcol = cb - 3072; }
      else if (cb < 6144) { cls = 2; dcol = cb - 4608 + 3072; }
      else if (cb < 6656) { cls = 2; scale = 0.08838834764831845f * 1.4426950408889634f; dcol = cb - 6144 + 4608; }
      else if (cb < 6720) { cls = 4; }
      else cls = 5;
    }
    if (cls <= 1) {
      const float inv = exp2f(-(float)l32 * (13.287712379549449f / 32.f));
#pragma unroll
      for (int tm = 0; tm < 2; ++tm)
#pragma unroll
        for (int i = 0; i < 16; ++i) {
          int r = rb0 + tm * 32 + (i >> 2) * 8 + hl * 4 + (i & 3);
          float rev = (float)p.pos[r] * inv * 0.15915494309189535f;
          rev -= floorf(rev);
          float sn = __builtin_amdgcn_sinf(rev), cs = __builtin_amdgcn_cosf(rev);
          float t1 = acc[tm][0][i], t2 = acc[tm][1][i];
          p.proj[(size_t)r * PLD + dcol + l32] = f2bf((t1 * cs - t2 * sn) * scale);
          p.proj[(size_t)r * PLD + dcol + 32 + l32] = f2bf((t2 * cs + t1 * sn) * scale);
        }
    } else if (cls == 2) {
#pragma unroll
      for (int tm = 0; tm < 2; ++tm)
#pragma unroll
        for (int tn = 0; tn < 2; ++tn)
#pragma unroll
          for (int i = 0; i < 16; ++i) {
            int r = rb0 + tm * 32 + (i >> 2) * 8 + hl * 4 + (i & 3);
            p.proj[(size_t)r * PLD + dcol + tn * 32 + l32] = f2bf(acc[tm][tn][i] * scale);
          }
    } else if (cls == 3) {
#pragma unroll
      for (int tm = 0; tm < 2; ++tm)
#pragma unroll
        for (int tn = 0; tn < 2; ++tn) {
          int c = dcol + tn * 32 + l32; int hh = c >> 7, d = c & 127;
#pragma unroll
          for (int g = 0; g < 4; ++g) {
            int r = rb0 + tm * 32 + g * 8 + hl * 4; int b = r >> 11, s = r & 2047;
            uint2 v; v.x = pack2(acc[tm][tn][g * 4], acc[tm][tn][g * 4 + 1]); v.y = pack2(acc[tm][tn][g * 4 + 2], acc[tm][tn][g * 4 + 3]);
            *(uint2*)(p.Vt + ((size_t)(b * 12 + hh) * 128 + d) * 2048 + s) = v;
          }
        }
    } else if (cls == 4) {
      if (l32 < 24 || true) {
#pragma unroll
        for (int tm = 0; tm < 2; ++tm)
#pragma unroll
          for (int tn = 0; tn < 2; ++tn) {
            int c = tn * 32 + l32;
            if (c < 48) {
#pragma unroll
              for (int i = 0; i < 16; ++i) {
                int r = rb0 + tm * 32 + (i >> 2) * 8 + hl * 4 + (i & 3);
                p.gates[(size_t)r * 48 + c] = acc[tm][tn][i];
              }
            }
          }
      }
    }
  } else if constexpr (EPI == EPI_MEMKV) {
    if (cb < 512) {
#pragma unroll
      for (int tm = 0; tm < 2; ++tm)
#pragma unroll
        for (int tn = 0; tn < 2; ++tn)
#pragma unroll
          for (int i = 0; i < 16; ++i) {
            int r = rb0 + tm * 32 + (i >> 2) * 8 + hl * 4 + (i & 3);
            p.memK[(size_t)r * 512 + cb + tn * 32 + l32] = f2bf(acc[tm][tn][i]);
          }
    } else {
#pragma unroll
      for (int tm = 0; tm < 2; ++tm)
#pragma unroll
        for (int tn = 0; tn < 2; ++tn) {
          int c = cb - 512 + tn * 32 + l32; int hh = c >> 7, d = c & 127;
#pragma unroll
          for (int g = 0; g < 4; ++g) {
            int r = rb0 + tm * 32 + g * 8 + hl * 4; int b = r >> 8, s = r & 255;
            uint2 v; v.x = pack2(acc[tm][tn][g * 4], acc[tm][tn][g * 4 + 1]); v.y = pack2(acc[tm][tn][g * 4 + 2], acc[tm][tn][g * 4 + 3]);
            *(uint2*)(p.memVt + ((size_t)(b * 4 + hh) * 128 + d) * 256 + s) = v;
          }
        }
    }
  } else if constexpr (EPI == EPI_OUT) {
#pragma unroll
    for (int tm = 0; tm < 2; ++tm)
#pragma unroll
      for (int tn = 0; tn < 2; ++tn)
#pragma unroll
        for (int i = 0; i < 16; ++i) {
          int r = rb0 + tm * 32 + (i >> 2) * 8 + hl * 4 + (i & 3);
          p.ybf[(size_t)r * 2048 + cb + tn * 32 + l32] = f2bf(acc[tm][tn][i]);
        }
  }
}

template <int EPI>
DEV void gemm_tile(const Params& p, const bf16* __restrict__ A, const bf16* __restrict__ Bt, int m0, int n0, int layer, char* smem) {
  bf16* As = (bf16*)smem;
  bf16* Bs = As + 2 * 128 * 72;
  const int tid = threadIdx.x, lane = tid & 63, w = tid >> 6, wm = w >> 2, wn = w & 3, l32 = lane & 31, hl = lane >> 5;
  f32x16 acc[2][2];
  for (int a = 0; a < 2; ++a) for (int b = 0; b < 2; ++b) acc[a][b] = zero16();
  uint4 s0a0, s0a1, s0b0, s0b1, s0b2, s0b3, s1a0, s1a1, s1b0, s1b1, s1b2, s1b3, s2a0, s2a1, s2b0, s2b1, s2b2, s2b3, s3a0, s3a1, s3b0, s3b1, s3b2, s3b3;
  const int lr = tid >> 3, lc = (tid & 7) * 8;
  const bf16* Ap = A + (size_t)(m0 + lr) * 2048 + lc;
  const bf16* Bp = Bt + (size_t)(n0 + lr) * 2048 + lc;
#define G_LOAD(S, k0) { S##a0 = *(const uint4*)(Ap + (k0)); S##a1 = *(const uint4*)(Ap + (size_t)64 * 2048 + (k0)); \
    S##b0 = *(const uint4*)(Bp + (k0)); S##b1 = *(const uint4*)(Bp + (size_t)64 * 2048 + (k0)); S##b2 = *(const uint4*)(Bp + (size_t)128 * 2048 + (k0)); S##b3 = *(const uint4*)(Bp + (size_t)192 * 2048 + (k0)); }
#define G_STORE(S, nb) { bf16* a_ = As + (nb) * 128 * 72 + lr * 72 + lc; bf16* b_ = Bs + (nb) * 256 * 72 + lr * 72 + lc; \
    *(uint4*)a_ = S##a0; *(uint4*)(a_ + 64 * 72) = S##a1; *(uint4*)b_ = S##b0; *(uint4*)(b_ + 64 * 72) = S##b1; *(uint4*)(b_ + 128 * 72) = S##b2; *(uint4*)(b_ + 192 * 72) = S##b3; }
#define G_COMPUTE(buf) { const bf16* Ab = As + (buf) * 128 * 72 + (wm * 64 + l32) * 72 + hl * 8; const bf16* Bb = Bs + (buf) * 256 * 72 + (wn * 64 + l32) * 72 + hl * 8; \
    _Pragma("unroll") for (int kk = 0; kk < 4; ++kk) { \
      bf16x8 a0 = ld8(Ab + kk * 16), a1 = ld8(Ab + 32 * 72 + kk * 16); bf16x8 b0 = ld8(Bb + kk * 16), b1 = ld8(Bb + 32 * 72 + kk * 16); \
      acc[0][0] = mfma32(a0, b0, acc[0][0]); acc[0][1] = mfma32(a0, b1, acc[0][1]); acc[1][0] = mfma32(a1, b0, acc[1][0]); acc[1][1] = mfma32(a1, b1, acc[1][1]); } }
  __syncthreads();
  G_LOAD(s0, 0); G_LOAD(s1, 64); G_LOAD(s2, 128); G_LOAD(s3, 192);
  G_STORE(s0, 0);
  __syncthreads();
  for (int kt = 0; kt < 32; kt += 4) {
    if (kt + 4 < 32) G_LOAD(s0, (kt + 4) * 64);
    G_COMPUTE(0); G_STORE(s1, 1); __syncthreads();
    if (kt + 5 < 32) G_LOAD(s1, (kt + 5) * 64);
    G_COMPUTE(1); G_STORE(s2, 0); __syncthreads();
    if (kt + 6 < 32) G_LOAD(s2, (kt + 6) * 64);
    G_COMPUTE(0); G_STORE(s3, 1); __syncthreads();
    if (kt + 7 < 32) G_LOAD(s3, (kt + 7) * 64);
    G_COMPUTE(1); if (kt + 4 < 32) G_STORE(s0, 0); __syncthreads();
  }
  const int cb = n0 + wn * 64;
  const int rb0 = m0 + wm * 64;
  if constexpr (EPI != EPI_PEERQ) {
    epi64<EPI>(p, layer, cb, rb0, l32, hl, acc[0][0], acc[0][1], acc[1][0], acc[1][1]);
  } else {
    __builtin_amdgcn_sched_barrier(0);
    const int head = n0 >> 8;
    bf16* ql = (bf16*)smem;
    bf16* skl = ql + 128 * 264;
#pragma unroll
    for (int tm = 0; tm < 2; ++tm)
#pragma unroll
      for (int tn = 0; tn < 2; ++tn)
#pragma unroll
        for (int i = 0; i < 16; ++i) {
          int r = wm * 64 + tm * 32 + (i >> 2) * 8 + hl * 4 + (i & 3);
          ql[r * 264 + wn * 64 + tn * 32 + l32] = f2bf(acc[tm][tn][i]);
        }
    const bf16* sksrc = p.SK + (size_t)(layer * 8 + head) * 2 * 128 * 128;
#pragma unroll 2
    for (int i = 0; i < 8; ++i) {
      int q = tid + i * 512; int row = q >> 4, cc = (q & 15) * 8;
      *(uint4*)(skl + row * 136 + cc) = *(const uint4*)(sksrc + row * 128 + cc);
    }
    __syncthreads();
    for (int a = 0; a < 2; ++a) for (int b = 0; b < 2; ++b) acc[a][b] = zero16();
    const int pp = wn >> 1;
    const bf16* Ab = ql + (wm * 64 + l32) * 264 + pp * 128 + hl * 8;
    const bf16* Bb = skl + (wn * 64 + l32) * 136 + hl * 8;
#pragma unroll
    for (int kk = 0; kk < 8; ++kk) {
      bf16x8 a0 = ld8(Ab + kk * 16), a1 = ld8(Ab + 32 * 264 + kk * 16);
      bf16x8 b0 = ld8(Bb + kk * 16), b1 = ld8(Bb + 32 * 136 + kk * 16);
      acc[0][0] = mfma32(a0, b0, acc[0][0]);
      acc[0][1] = mfma32(a0, b1, acc[0][1]);
      acc[1][0] = mfma32(a1, b0, acc[1][0]);
      acc[1][1] = mfma32(a1, b1, acc[1][1]);
    }
    __syncthreads();
    uint32_t* sc = (uint32_t*)smem;
#pragma unroll
    for (int tm = 0; tm < 2; ++tm)
#pragma unroll
      for (int tn = 0; tn < 2; ++tn)
#pragma unroll
        for (int i = 0; i < 16; ++i) {
          int r = wm * 64 + tm * 32 + (i >> 2) * 8 + hl * 4 + (i & 3);
          const int col = wn * 64 + tn * 32 + l32;
          uint32_t u = __float_as_uint(acc[tm][tn][i]);
          u = (u & 0x80000000u) ? ~u : (u | 0x80000000u);
          sc[r * 260 + col] = (u & ~127u) | (uint32_t)(127 - (col & 127));
        }
    __syncthreads();
    const int sub = lane & 15;
    for (int rd = 0; rd < 8; ++rd) {
      int pr = rd * 32 + w * 4 + (lane >> 4);
      int tok = pr >> 1, ph = pr & 1;
      const uint32_t* src = sc + tok * 260 + ph * 128 + sub * 8;
      uint4 v0 = *(const uint4*)src, v1 = *(const uint4*)(src + 4);
      uint32_t v[8] = {v0.x, v0.y, v0.z, v0.w, v1.x, v1.y, v1.z, v1.w};
      uint32_t mykey = 0;
#define CE_(i, j) { const uint32_t hi_ = max(v[i], v[j]), lo_ = min(v[i], v[j]); v[i] = hi_; v[j] = lo_; }
      CE_(0, 1) CE_(2, 3) CE_(4, 5) CE_(6, 7)
      CE_(0, 2) CE_(1, 3) CE_(4, 6) CE_(5, 7)
      CE_(1, 2) CE_(5, 6)
      CE_(0, 4) CE_(1, 5) CE_(2, 6) CE_(3, 7)
      CE_(2, 4) CE_(3, 5)
      CE_(1, 2) CE_(3, 4) CE_(5, 6)
#undef CE_
      for (int it = 0; it < 16; ++it) {
        uint32_t m = v[0];
        m = max(m, (uint32_t)__builtin_amdgcn_update_dpp(0, (int)m, 0x128, 0xF, 0xF, false));
        m = max(m, (uint32_t)__builtin_amdgcn_update_dpp(0, (int)m, 0x124, 0xF, 0xF, false));
        m = max(m, (uint32_t)__builtin_amdgcn_update_dpp(0, (int)m, 0x122, 0xF, 0xF, false));
        m = max(m, (uint32_t)__builtin_amdgcn_update_dpp(0, (int)m, 0x121, 0xF, 0xF, false));
        if (sub == it) mykey = m;
        const bool pop = (v[0] == m);
#pragma unroll
        for (int j = 0; j < 7; ++j) v[j] = pop ? v[j + 1] : v[j];
        v[7] = pop ? 0u : v[7];
      }
      uint32_t vb = mykey & ~127u;
      vb = (vb & 0x80000000u) ? (vb & 0x7fffffffu) : ~vb;
      size_t o = ((size_t)(m0 + tok) * 8 + head) * 32 + ph * 16 + sub;
      p.sv[o] = __uint_as_float(vb); p.si[o] = 127 - (int)(mykey & 127u);
    }
  }
}

template <int EPI>
DEV void phase_gemm(const Params& p, const bf16* A, const bf16* Bt, int mtiles, int ntiles, int layer, char* smem, int base, int total) {
  for (int it = blockIdx.x; it < total; it += gridDim.x) {
    int t = it - base;
    if (t < 0 || t >= mtiles * ntiles) continue;
    int mt = t % mtiles, nt = t / mtiles;
    gemm_tile<EPI>(p, A, Bt, mt * 128, nt * 256, layer, smem);
  }
}

template <int EPI>
DEV void gemm_tile2(const Params& p, const bf16* __restrict__ A, const bf16* __restrict__ Bt, int m0, int n0, int layer, char* smem) {
  bf16* As = (bf16*)smem;
  bf16* Bs = As + 2 * 256 * 72;
  const int tid = threadIdx.x, lane = tid & 63, w = tid >> 6, wm = w >> 1, wn = w & 1, l32 = lane & 31, hl = lane >> 5;
  f32x16 acc[2][4];
#pragma unroll
  for (int a = 0; a < 2; ++a)
#pragma unroll
    for (int b = 0; b < 4; ++b) acc[a][b] = zero16();
  uint4 t0a0, t0a1, t0a2, t0a3, t0b0, t0b1, t0b2, t0b3;
  const int lr = tid >> 3, lc = (tid & 7) * 8;
  const bf16* Ap = A + (size_t)(m0 + lr) * 2048 + lc;
  const bf16* Bp = Bt + (size_t)(n0 + lr) * 2048 + lc;
#define H_LOAD(S, KOFF) { S##a0 = *(const uint4*)(Ap + (KOFF)); S##a1 = *(const uint4*)(Ap + (size_t)64 * 2048 + (KOFF)); S##a2 = *(const uint4*)(Ap + (size_t)128 * 2048 + (KOFF)); S##a3 = *(const uint4*)(Ap + (size_t)192 * 2048 + (KOFF)); \
    S##b0 = *(const uint4*)(Bp + (KOFF)); S##b1 = *(const uint4*)(Bp + (size_t)64 * 2048 + (KOFF)); S##b2 = *(const uint4*)(Bp + (size_t)128 * 2048 + (KOFF)); S##b3 = *(const uint4*)(Bp + (size_t)192 * 2048 + (KOFF)); }
#define H_STORE(S, nb) { bf16* a_ = As + (nb) * 256 * 72 + lr * 72 + lc; bf16* b_ = Bs + (nb) * 256 * 72 + lr * 72 + lc; \
    *(uint4*)a_ = S##a0; *(uint4*)(a_ + 64 * 72) = S##a1; *(uint4*)(a_ + 128 * 72) = S##a2; *(uint4*)(a_ + 192 * 72) = S##a3; \
    *(uint4*)b_ = S##b0; *(uint4*)(b_ + 64 * 72) = S##b1; *(uint4*)(b_ + 128 * 72) = S##b2; *(uint4*)(b_ + 192 * 72) = S##b3; }
#define H_FRAGS(F, Ab, Bb, kk) { F##a0 = ld8(Ab + (kk) * 16); F##a1 = ld8(Ab + 32 * 72 + (kk) * 16); \
    F##b0 = ld8(Bb + (kk) * 16); F##b1 = ld8(Bb + 32 * 72 + (kk) * 16); F##b2 = ld8(Bb + 64 * 72 + (kk) * 16); F##b3 = ld8(Bb + 96 * 72 + (kk) * 16); }
#define H_MFMA8(F) { acc[0][0] = mfma32(F##a0, F##b0, acc[0][0]); acc[0][1] = mfma32(F##a0, F##b1, acc[0][1]); acc[0][2] = mfma32(F##a0, F##b2, acc[0][2]); acc[0][3] = mfma32(F##a0, F##b3, acc[0][3]); \
    acc[1][0] = mfma32(F##a1, F##b0, acc[1][0]); acc[1][1] = mfma32(F##a1, F##b1, acc[1][1]); acc[1][2] = mfma32(F##a1, F##b2, acc[1][2]); acc[1][3] = mfma32(F##a1, F##b3, acc[1][3]); }
#define H_SCHED_RM() {}
#define H_COMPUTE(buf) { const bf16* Ab = As + (buf) * 256 * 72 + (wm * 64 + l32) * 72 + hl * 8; const bf16* Bb = Bs + (buf) * 256 * 72 + (wn * 128 + l32) * 72 + hl * 8; \
    bf16x8 fa0, fa1, fb0, fb1, fb2, fb3, ga0, ga1, gb0, gb1, gb2, gb3; \
    H_FRAGS(f, Ab, Bb, 0); \
    H_FRAGS(g, Ab, Bb, 1); H_MFMA8(f); H_SCHED_RM(); \
    H_FRAGS(f, Ab, Bb, 2); H_MFMA8(g); H_SCHED_RM(); \
    H_FRAGS(g, Ab, Bb, 3); H_MFMA8(f); H_SCHED_RM(); \
    H_MFMA8(g); }
  __syncthreads();
  H_LOAD(t0, 0);
  H_STORE(t0, 0);
  H_LOAD(t0, 64);
  __syncthreads();
  for (int kt = 0; kt < 32; kt += 2) {
    H_STORE(t0, 1);
    if (kt + 2 < 32) H_LOAD(t0, (kt + 2) * 64);
    H_COMPUTE(0); __syncthreads();
    if (kt + 2 < 32) H_STORE(t0, 0);
    if (kt + 3 < 32) H_LOAD(t0, (kt + 3) * 64);
    H_COMPUTE(1); __syncthreads();
  }
  if constexpr (EPI == EPI_PEERQ) {
    const int head = n0 >> 8;
    const int wm2 = w >> 2, wn2 = w & 3;
    bf16* ql = (bf16*)smem;
    bf16* skl = ql + 128 * 264;
    const bf16* sksrc = p.SK + (size_t)(layer * 8 + head) * 2 * 128 * 128 + (size_t)(tid >> 4) * 128 + (tid & 15) * 8;
#pragma unroll 1
    for (int half = 0; half < 2; ++half) {
      const int mb = m0 + half * 128;
      __syncthreads();
      if ((wm >> 1) == half) {
#pragma unroll
        for (int tm = 0; tm < 2; ++tm)
#pragma unroll
          for (int tn = 0; tn < 4; ++tn)
#pragma unroll
            for (int i = 0; i < 16; ++i) {
              int r = (wm & 1) * 64 + tm * 32 + (i >> 2) * 8 + hl * 4 + (i & 3);
              ql[r * 264 + wn * 128 + tn * 32 + l32] = f2bf(acc[tm][tn][i]);
            }
      }
      __builtin_amdgcn_sched_barrier(0);
#pragma unroll 1
      for (int bt = 0; bt < 2; ++bt) {
        const bf16* s_ = sksrc + bt * 128 * 128;
        const uint4 k0 = *(const uint4*)(s_), k1 = *(const uint4*)(s_ + 32 * 128), k2 = *(const uint4*)(s_ + 64 * 128), k3 = *(const uint4*)(s_ + 96 * 128);
        bf16* d_ = skl + (bt * 128 + (tid >> 4)) * 136 + (tid & 15) * 8;
        *(uint4*)(d_) = k0; *(uint4*)(d_ + 32 * 136) = k1; *(uint4*)(d_ + 64 * 136) = k2; *(uint4*)(d_ + 96 * 136) = k3;
      }
      __syncthreads();
      f32x16 sacc[2][2];
      for (int a = 0; a < 2; ++a) for (int b = 0; b < 2; ++b) sacc[a][b] = zero16();
      const int pp = wn2 >> 1;
      const bf16* Ab = ql + (wm2 * 64 + l32) * 264 + pp * 128 + hl * 8;
      const bf16* Bb = skl + (wn2 * 64 + l32) * 136 + hl * 8;
  #pragma unroll
      for (int kk = 0; kk < 8; ++kk) {
        bf16x8 a0 = ld8(Ab + kk * 16), a1 = ld8(Ab + 32 * 264 + kk * 16);
        bf16x8 b0 = ld8(Bb + kk * 16), b1 = ld8(Bb + 32 * 136 + kk * 16);
        sacc[0][0] = mfma32(a0, b0, sacc[0][0]);
        sacc[0][1] = mfma32(a0, b1, sacc[0][1]);
        sacc[1][0] = mfma32(a1, b0, sacc[1][0]);
        sacc[1][1] = mfma32(a1, b1, sacc[1][1]);
      }
      __syncthreads();
      uint32_t* sc = (uint32_t*)smem;
  #pragma unroll
      for (int tm = 0; tm < 2; ++tm)
  #pragma unroll
        for (int tn = 0; tn < 2; ++tn)
  #pragma unroll
          for (int i = 0; i < 16; ++i) {
            int r = wm2 * 64 + tm * 32 + (i >> 2) * 8 + hl * 4 + (i & 3);
            const int col = wn2 * 64 + tn * 32 + l32;
            uint32_t u = __float_as_uint(sacc[tm][tn][i]);
            u = (u & 0x80000000u) ? ~u : (u | 0x80000000u);
            sc[r * 260 + col] = (u & ~127u) | (uint32_t)(127 - (col & 127));
          }
      __syncthreads();
      const int sub = lane & 15;
      for (int rd = 0; rd < 8; ++rd) {
        int pr = rd * 32 + w * 4 + (lane >> 4);
        int tok = pr >> 1, ph = pr & 1;
        const uint32_t* src = sc + tok * 260 + ph * 128 + sub * 8;
        uint4 v0 = *(const uint4*)src, v1 = *(const uint4*)(src + 4);
        uint32_t v[8] = {v0.x, v0.y, v0.z, v0.w, v1.x, v1.y, v1.z, v1.w};
        uint32_t mykey = 0;
  #define CE_(i, j) { const uint32_t hi_ = max(v[i], v[j]), lo_ = min(v[i], v[j]); v[i] = hi_; v[j] = lo_; }
        CE_(0, 1) CE_(2, 3) CE_(4, 5) CE_(6, 7)
        CE_(0, 2) CE_(1, 3) CE_(4, 6) CE_(5, 7)
        CE_(1, 2) CE_(5, 6)
        CE_(0, 4) CE_(1, 5) CE_(2, 6) CE_(3, 7)
        CE_(2, 4) CE_(3, 5)
        CE_(1, 2) CE_(3, 4) CE_(5, 6)
  #undef CE_
        for (int it = 0; it < 16; ++it) {
          uint32_t m = v[0];
          m = max(m, (uint32_t)__builtin_amdgcn_update_dpp(0, (int)m, 0x128, 0xF, 0xF, false));
          m = max(m, (uint32_t)__builtin_amdgcn_update_dpp(0, (int)m, 0x124, 0xF, 0xF, false));
          m = max(m, (uint32_t)__builtin_amdgcn_update_dpp(0, (int)m, 0x122, 0xF, 0xF, false));
          m = max(m, (uint32_t)__builtin_amdgcn_update_dpp(0, (int)m, 0x121, 0xF, 0xF, false));
          if (sub == it) mykey = m;
          const bool pop = (v[0] == m);
  #pragma unroll
          for (int j = 0; j < 7; ++j) v[j] = pop ? v[j + 1] : v[j];
          v[7] = pop ? 0u : v[7];
        }
        uint32_t vb = mykey & ~127u;
        vb = (vb & 0x80000000u) ? (vb & 0x7fffffffu) : ~vb;
        size_t o = ((size_t)(mb + tok) * 8 + head) * 32 + ph * 16 + sub;
        p.sv[o] = __uint_as_float(vb); p.si[o] = 127 - (int)(mykey & 127u);
      }
    }
  } else {
  const int rb0 = m0 + wm * 64;
  epi64<EPI>(p, layer, n0 + wn * 128, rb0, l32, hl, acc[0][0], acc[0][1], acc[1][0], acc[1][1]);
  epi64<EPI>(p, layer, n0 + wn * 128 + 64, rb0, l32, hl, acc[0][2], acc[0][3], acc[1][2], acc[1][3]);
  }
}

template <int EPI>
DEV void phase_gemm2(const Params& p, const bf16* A, const bf16* Bt, int mtiles, int ntiles, int layer, char* smem, int base, int total) {
  for (int it = blockIdx.x; it < total; it += gridDim.x) {
    int t = it - base;
    if (t < 0 || t >= mtiles * ntiles) continue;
    int mt = t % mtiles, nt = t / mtiles;
    gemm_tile2<EPI>(p, A, Bt, mt * 256, nt * 256, layer, smem);
  }
}

DEV void phase_ln(const Params& p, const float* g, const float* bta, const float* hin) {
  const int lane = threadIdx.x & 63, w = threadIdx.x >> 6;
  for (int t = blockIdx.x * 8 + w; t < T_; t += gridDim.x * 8) {
    float* row = p.hf + (size_t)t * 2048;
    const float* hrow = hin + (size_t)t * 2048;
    const bf16* yrow = p.ybf + (size_t)t * 2048;
    float4 v[8]; float s = 0.f;
#pragma unroll
    for (int c = 0; c < 8; ++c) {
      const float4 hh = *(const float4*)(hrow + c * 256 + lane * 4); const uint2 yy = *(const uint2*)(yrow + c * 256 + lane * 4);
      v[c].x = DN_ALPHA * hh.x + bflo(yy.x); v[c].y = DN_ALPHA * hh.y + bfhi(yy.x); v[c].z = DN_ALPHA * hh.z + bflo(yy.y); v[c].w = DN_ALPHA * hh.w + bfhi(yy.y);
      s += v[c].x + v[c].y + v[c].z + v[c].w;
    }
    float mu = wave_sum(s) * (1.f / 2048.f);
    float q = 0.f;
#pragma unroll
    for (int c = 0; c < 8; ++c) { float a = v[c].x - mu, b = v[c].y - mu, cc = v[c].z - mu, d = v[c].w - mu; q += a * a + b * b + cc * cc + d * d; }
    float rstd = rsqrtf(wave_sum(q) * (1.f / 2048.f) + LN_EPS);
#pragma unroll
    for (int c = 0; c < 8; ++c) {
      int o = c * 256 + lane * 4;
      float4 gg = *(const float4*)(g + o), bb = *(const float4*)(bta + o), r;
      r.x = (v[c].x - mu) * rstd * gg.x + bb.x; r.y = (v[c].y - mu) * rstd * gg.y + bb.y;
      r.z = (v[c].z - mu) * rstd * gg.z + bb.z; r.w = (v[c].w - mu) * rstd * gg.w + bb.w;
      *(float4*)(row + o) = r;
      uint2 h; h.x = pack2(r.x, r.y); h.y = pack2(r.z, r.w);
      *(uint2*)(p.hbf + (size_t)t * 2048 + o) = h;
    }
  }
}

template <int DQ, int NMAP>
DEV void attn_core(const bf16* __restrict__ Qp, int ldq, const bf16* __restrict__ Kp, int ldk,
                   const bf16* __restrict__ Vtp, int ldvt, int nkeys, char* smem, f32x16 (&o)[4], float& ltot) {
  bf16* Ks = (bf16*)smem;
  bf16* Vs = Ks + 2 * 64 * 136;
  const int tid = threadIdx.x, lane = tid & 63, w = tid >> 6, l32 = lane & 31, hl = lane >> 5;
  const int qg = NMAP == 2 ? (w & 3) : w, mp = NMAP == 2 ? (w >> 2) : 0;
  bf16x8 qf[DQ / 16];
#pragma unroll
  for (int kk = 0; kk < DQ / 16; ++kk) qf[kk] = ld8(Qp + (size_t)(qg * 32 + l32) * ldq + mp * DQ + kk * 16 + hl * 8);
#pragma unroll
  for (int d = 0; d < 4; ++d) o[d] = zero16();
  float m_run = -1e30f, l_run = 0.f;
  uint4 rk0, rk1, rv0, rv1;
  const int kr = tid >> 4, kc = (tid & 15) * 8;
  const int vr = tid >> 3, vc = (tid & 7) * 8;
  const bf16* Kg = Kp + (size_t)kr * ldk + kc;
  const bf16* Vg = Vtp + (size_t)vr * ldvt + vc;
  __syncthreads();
  rk0 = *(const uint4*)(Kg); rk1 = *(const uint4*)(Kg + (size_t)32 * ldk);
  rv0 = *(const uint4*)(Vg); rv1 = *(const uint4*)(Vg + (size_t)64 * ldvt);
  *(uint4*)(Ks + kr * 136 + kc) = rk0; *(uint4*)(Ks + (kr + 32) * 136 + kc) = rk1;
  *(uint4*)(Vs + vr * 72 + vc) = rv0; *(uint4*)(Vs + (vr + 64) * 72 + vc) = rv1;
  __syncthreads();
  const int ntile = nkeys >> 6;
  for (int kt = 0; kt < ntile; ++kt) {
    const int buf = kt & 1;
    if (kt + 1 < ntile) {
      const int k0 = (kt + 1) * 64;
      rk0 = *(const uint4*)(Kg + (size_t)k0 * ldk); rk1 = *(const uint4*)(Kg + (size_t)(k0 + 32) * ldk);
      rv0 = *(const uint4*)(Vg + k0); rv1 = *(const uint4*)(Vg + (size_t)64 * ldvt + k0);
    }
    const bf16* Kb = Ks + buf * 64 * 136 + l32 * 136 + mp * DQ + hl * 8;
    const bf16* Vb = Vs + buf * 128 * 72 + l32 * 72 + hl * 4;
    f32x16 s[2];
#pragma unroll
    for (int st = 0; st < 2; ++st) {
      s[st] = zero16();
#pragma unroll
      for (int kk = 0; kk < DQ / 16; ++kk) s[st] = mfma32(ld8(Kb + st * 32 * 136 + kk * 16), qf[kk], s[st]);
    }
    float mx = s[0][0];
#pragma unroll
    for (int i = 0; i < 16; ++i) { mx = fmaxf(mx, s[0][i]); mx = fmaxf(mx, s[1][i]); }
    mx = fmaxf(mx, __shfl_xor(mx, 32));
    float mnew = fmaxf(m_run, mx);
    float alpha = __builtin_amdgcn_exp2f(m_run - mnew); m_run = mnew;
    float rs = 0.f;
#pragma unroll
    for (int i = 0; i < 16; ++i) { s[0][i] = __builtin_amdgcn_exp2f(s[0][i] - mnew); s[1][i] = __builtin_amdgcn_exp2f(s[1][i] - mnew); rs += s[0][i] + s[1][i]; }
    l_run = l_run * alpha + rs;
    if (__builtin_amdgcn_ballot_w64(alpha != 1.f) != 0) {
#pragma unroll
      for (int d = 0; d < 4; ++d)
#pragma unroll
        for (int i = 0; i < 16; ++i) o[d][i] *= alpha;
    }
#pragma unroll
    for (int st = 0; st < 2; ++st)
#pragma unroll
      for (int hs = 0; hs < 2; ++hs) {
        bf16x8 pb = mk8(pack2(s[st][hs * 8 + 0], s[st][hs * 8 + 1]), pack2(s[st][hs * 8 + 2], s[st][hs * 8 + 3]),
                        pack2(s[st][hs * 8 + 4], s[st][hs * 8 + 5]), pack2(s[st][hs * 8 + 6], s[st][hs * 8 + 7]));
#pragma unroll
        for (int d = 0; d < 4; ++d) {
          const bf16* vp = Vb + d * 32 * 72 + st * 32 + hs * 16;
          uint2 x0 = *(const uint2*)vp, x1 = *(const uint2*)(vp + 8);
          o[d] = mfma32(mk8(x0.x, x0.y, x1.x, x1.y), pb, o[d]);
        }
      }
    if (kt + 1 < ntile) {
      const int nb = buf ^ 1;
      *(uint4*)(Ks + nb * 64 * 136 + kr * 136 + kc) = rk0; *(uint4*)(Ks + nb * 64 * 136 + (kr + 32) * 136 + kc) = rk1;
      *(uint4*)(Vs + nb * 128 * 72 + vr * 72 + vc) = rv0; *(uint4*)(Vs + nb * 128 * 72 + (vr + 64) * 72 + vc) = rv1;
    }
    __syncthreads();
  }
  ltot = l_run + __shfl_xor(l_run, 32);
}

DEV void mem_attn_item(const Params& p, int it, int qmcol, char* smem) {
  const int b = it >> 5, mh = (it >> 3) & 3, qb = it & 7;
  const int lane = threadIdx.x & 63, w = threadIdx.x >> 6, l32 = lane & 31, hl = lane >> 5;
  f32x16 o[4]; float lt;
  const size_t t0 = (size_t)b * 2048 + qb * 256;
  attn_core<128, 1>(p.proj + t0 * PLD + qmcol + mh * 128, PLD, p.memK + (size_t)b * 256 * 512 + mh * 128, 512,
                    p.memVt + (size_t)(b * 4 + mh) * 128 * 256, 256, 256, smem, o, lt);
  const float inv = 1.f / lt;
  bf16* dst = p.hbf + (t0 + w * 32 + l32) * 2048 + 1536 + mh * 128;
#pragma unroll
  for (int d = 0; d < 4; ++d)
#pragma unroll
    for (int g = 0; g < 4; ++g) {
      uint2 v; v.x = pack2(o[d][g * 4] * inv, o[d][g * 4 + 1] * inv); v.y = pack2(o[d][g * 4 + 2] * inv, o[d][g * 4 + 3] * inv);
      *(uint2*)(dst + d * 32 + g * 8 + hl * 4) = v;
    }
}

DEV void diff_attn_item(const Params& p, int it, float lam, char* smem) {
  const int qb = it & 15, hh = (it >> 4) % 12, b = it / 192;
  const int lane = threadIdx.x & 63, w = threadIdx.x >> 6, l32 = lane & 31, hl = lane >> 5;
  const int qg = w & 3, mp = w >> 2;
  f32x16 o[4]; float lt;
  const size_t t0 = (size_t)b * 2048 + qb * 128;
  attn_core<64, 2>(p.proj + t0 * PLD + hh * 128, PLD, p.proj + (size_t)b * 2048 * PLD + 1536 + hh * 128, PLD,
                   p.Vt + (size_t)(b * 12 + hh) * 128 * 2048, 2048, 2048, smem, o, lt);
  const float inv = 1.f / lt;
  float* ob = (float*)smem;
  if (mp == 1) {
#pragma unroll
    for (int d = 0; d < 4; ++d)
#pragma unroll
      for (int g = 0; g < 4; ++g) {
        float4 v; v.x = o[d][g * 4] * inv; v.y = o[d][g * 4 + 1] * inv; v.z = o[d][g * 4 + 2] * inv; v.w = o[d][g * 4 + 3] * inv;
        *(float4*)(ob + (qg * 32 + l32) * 132 + d * 32 + g * 8 + hl * 4) = v;
      }
  }
  __syncthreads();
  if (mp == 0) {
    float ss = 0.f;
#pragma unroll
    for (int d = 0; d < 4; ++d)
#pragma unroll
      for (int g = 0; g < 4; ++g) {
        float4 v = *(const float4*)(ob + (qg * 32 + l32) * 132 + d * 32 + g * 8 + hl * 4);
        o[d][g * 4] = o[d][g * 4] * inv - lam * v.x; o[d][g * 4 + 1] = o[d][g * 4 + 1] * inv - lam * v.y;
        o[d][g * 4 + 2] = o[d][g * 4 + 2] * inv - lam * v.z; o[d][g * 4 + 3] = o[d][g * 4 + 3] * inv - lam * v.w;
        ss += o[d][g * 4] * o[d][g * 4] + o[d][g * 4 + 1] * o[d][g * 4 + 1] + o[d][g * 4 + 2] * o[d][g * 4 + 2] + o[d][g * 4 + 3] * o[d][g * 4 + 3];
      }
    ss += __shfl_xor(ss, 32);
    const float rn = rsqrtf(ss * (1.f / 128.f) + LN_EPS) * 0.8f;
    const float* gn = p.attn_hn + hh * 128;
    bf16* dst = p.hbf + (t0 + qg * 32 + l32) * 2048 + hh * 128;
#pragma unroll
    for (int d = 0; d < 4; ++d)
#pragma unroll
      for (int g = 0; g < 4; ++g) {
        int c = d * 32 + g * 8 + hl * 4;
        float4 gg = *(const float4*)(gn + c);
        uint2 v; v.x = pack2(o[d][g * 4] * rn * gg.x, o[d][g * 4 + 1] * rn * gg.y); v.y = pack2(o[d][g * 4 + 2] * rn * gg.z, o[d][g * 4 + 3] * rn * gg.w);
        *(uint2*)(dst + c) = v;
      }
  }
  __syncthreads();
}

DEV void phase_attn0(const Params& p, char* smem) {
  float a = 0.f, c = 0.f;
  for (int i = 0; i < 64; ++i) { a += p.attn_lam[i] * p.attn_lam[64 + i]; c += p.attn_lam[128 + i] * p.attn_lam[192 + i]; }
  const float lam = expf(a) - expf(c) + 0.2f;
  for (int it = blockIdx.x; it < 1536 + 256; it += gridDim.x) {
    if (it < 1536) diff_attn_item(p, it, lam, smem);
    else mem_attn_item(p, it - 1536, 3072, smem);
  }
}

DEV float log_sigmoid(float x) { return fminf(x, 0.f) - log1pf(expf(-fabsf(x))); }

DEV void gate_vectors(const Params& p, int b, int hh, int dir, int c, int lane, float& R0, float& R1, float& C0, float& C1, float& total) {
  const size_t t = (size_t)b * 2048 + c * 128 + lane * 2;
  const int ci = (2 * dir) * 12 + hh, cf = (2 * dir + 1) * 12 + hh;
  float i0 = p.gates[t * 48 + ci] + p.ml_gb[ci], i1 = p.gates[(t + 1) * 48 + ci] + p.ml_gb[ci];
  float f0 = log_sigmoid(p.gates[t * 48 + cf] + p.ml_gb[cf]), f1 = log_sigmoid(p.gates[(t + 1) * 48 + cf] + p.ml_gb[cf]);
  float s = f0 + f1;
  for (int o = 1; o < 64; o <<= 1) { float u = __shfl_up(s, o); if (lane >= o) s += u; }
  total = __shfl(s, 63);
  float p1 = s, p0 = s - f1;
  if (dir == 0) { R0 = p0; R1 = p1; }
  else { R0 = total - (p0 - f0); R1 = total - (p1 - f1); }
  C0 = i0 - R0; C1 = i1 - R1;
}

DEV void ml_summary_item(const Params& p, int it, char* smem) {
  const int c = it & 15, dir = (it >> 4) & 1, bh = it >> 5, hh = bh % 12, b = bh / 12;
  bf16* kwT = (bf16*)smem;
  bf16* vT = kwT + 128 * 136;
  float* wa = (float*)(vT + 128 * 136);
  const int tid = threadIdx.x, lane = tid & 63, w = tid >> 6, l32 = lane & 31, hl = lane >> 5;
  __syncthreads();
  if (w == 0) {
    float R0, R1, C0, C1, tot; gate_vectors(p, b, hh, dir, c, lane, R0, R1, C0, C1, tot);
    float a0 = tot + C0, a1 = tot + C1;
    float am = wave_max(fmaxf(a0, a1));
    wa[lane * 2] = expf(a0 - am); wa[lane * 2 + 1] = expf(a1 - am);
    if (lane == 0) { p.scal[it * 2] = tot; p.scal[it * 2 + 1] = am; }
  }
  const size_t t0 = (size_t)b * 2048 + c * 128;
  const bf16* vsrc = p.Vt + (size_t)(b * 12 + hh) * 128 * 2048 + c * 128;
#pragma unroll
  for (int i = 0; i < 4; ++i) { int q = tid + i * 512; int r = q >> 4, cc = (q & 15) * 8; *(uint4*)(vT + r * 136 + cc) = *(const uint4*)(vsrc + (size_t)r * 2048 + cc); }
  __syncthreads();
  const bf16* ksrc = p.proj + t0 * PLD + 1536 + hh * 128;
#pragma unroll
  for (int i = 0; i < 4; ++i) {
    int q = tid + i * 512; int s = q & 127, kc = (q >> 7) * 8;
    uint4 kv = *(const uint4*)(ksrc + (size_t)s * PLD + kc);
    float wgt = wa[s];
    uint32_t u[4] = {kv.x, kv.y, kv.z, kv.w};
#pragma unroll
    for (int j = 0; j < 4; ++j) { kwT[(kc + 2 * j) * 136 + s] = f2bf(bflo(u[j]) * wgt); kwT[(kc + 2 * j + 1) * 136 + s] = f2bf(bfhi(u[j]) * wgt); }
  }
  __syncthreads();
  const int mt = w >> 1, ntb = (w & 1) * 2;
  f32x16 acc[2] = {zero16(), zero16()};
#pragma unroll
  for (int kk = 0; kk < 8; ++kk) {
    bf16x8 a = ld8(vT + (mt * 32 + l32) * 136 + kk * 16 + hl * 8);
#pragma unroll
    for (int n = 0; n < 2; ++n) acc[n] = mfma32(a, ld8(kwT + ((ntb + n) * 32 + l32) * 136 + kk * 16 + hl * 8), acc[n]);
  }
  bf16* dst = p.kvT + (size_t)it * 16384;
#pragma unroll
  for (int n = 0; n < 2; ++n)
#pragma unroll
    for (int i = 0; i < 16; ++i) dst[(mt * 32 + (i >> 2) * 8 + hl * 4 + (i & 3)) * 128 + (ntb + n) * 32 + l32] = f2bf(acc[n][i]);
  if (tid < 128) {
    float s = 0.f;
    for (int j = 0; j < 128; ++j) s += bf2f(kwT[tid * 136 + j]);
    p.nvec[(size_t)it * 128 + tid] = s;
  }
}

DEV void ml_scan_item(const Params& p, int it) {
  const int slab = it & 3, bhd = it >> 2, dir = bhd & 1, tid = threadIdx.x;
  float C[8];
#pragma unroll
  for (int j = 0; j < 8; ++j) C[j] = 0.f;
  float4 Nn = make_float4(0.f, 0.f, 0.f, 0.f);
  float m = 0.f;
  const bool doN = (slab == 0 && tid < 32);
  const size_t eoff = (size_t)slab * 4096 + tid * 8;
  uint4 cur = *(const uint4*)(p.kvT + (size_t)(bhd * 16 + (dir ? 15 : 0)) * 16384 + eoff);
  for (int cc = 0; cc < 16; ++cc) {
    const int c = dir ? 15 - cc : cc;
    const int id9 = bhd * 16 + c;
    uint4 nxt = make_uint4(0u, 0u, 0u, 0u);
    if (cc + 1 < 16) nxt = *(const uint4*)(p.kvT + (size_t)(bhd * 16 + (dir ? 14 - cc : cc + 1)) * 16384 + eoff);
    const float bl = p.scal[id9 * 2], am = p.scal[id9 * 2 + 1];
    uint4 st; st.x = pack2(C[0], C[1]); st.y = pack2(C[2], C[3]); st.z = pack2(C[4], C[5]); st.w = pack2(C[6], C[7]);
    *(uint4*)(p.kvT + (size_t)id9 * 16384 + eoff) = st;
    float4 nn = make_float4(0.f, 0.f, 0.f, 0.f);
    if (doN) { float4* pn = (float4*)(p.nvec + (size_t)id9 * 128 + tid * 4); nn = *pn; *pn = Nn; }
    if (slab == 0 && tid == 0) p.mst[id9] = m;
    const float mn = fmaxf(bl + m, am);
    const float dec = expf(bl + m - mn), ww = expf(am - mn);
    const float kv[8] = {bflo(cur.x), bfhi(cur.x), bflo(cur.y), bfhi(cur.y), bflo(cur.z), bfhi(cur.z), bflo(cur.w), bfhi(cur.w)};
#pragma unroll
    for (int j = 0; j < 8; ++j) C[j] = dec * C[j] + ww * kv[j];
    Nn.x = dec * Nn.x + ww * nn.x; Nn.y = dec * Nn.y + ww * nn.y; Nn.z = dec * Nn.z + ww * nn.z; Nn.w = dec * Nn.w + ww * nn.w;
    m = mn; cur = nxt;
  }
}

DEV void ml_out_item(const Params& p, int it, char* smem) {
  const int c = it & 15, bh = it >> 4, hh = bh % 12, b = bh / 12;
  bf16* ks = (bf16*)smem;
  bf16* vT = ks + 128 * 136;
  bf16* CT = vT + 128 * 136;
  float* vec = (float*)(CT + 2 * 128 * 136);
  float *Rv = vec, *Cv = vec + 256, *Mv = vec + 512, *nS = vec + 768, *msv = vec + 1024;
  const int tid = threadIdx.x, lane = tid & 63, w = tid >> 6, l32 = lane & 31, hl = lane >> 5;
  const int dir = w >> 2, qg = w & 3;
  const size_t t0 = (size_t)b * 2048 + c * 128;
  __syncthreads();
  if (w < 2) {
    const int dr = w;
    const int id9 = (bh * 2 + dr) * 16 + c;
    float R0, R1, C0, C1, tot; gate_vectors(p, b, hh, dr, c, lane, R0, R1, C0, C1, tot);
    const float ms = p.mst[id9];
    float mx = fmaxf(C0, C1), x0, x1;
    if (dr == 0) {
      for (int o = 1; o < 64; o <<= 1) { float u = __shfl_up(mx, o); if (lane >= o) mx = fmaxf(mx, u); }
      float prev = __shfl_up(mx, 1); if (lane == 0) prev = -3.0e38f;
      x0 = fmaxf(prev, C0); x1 = mx;
    } else {
      for (int o = 1; o < 64; o <<= 1) { float u = __shfl_down(mx, o); if (lane + o < 64) mx = fmaxf(mx, u); }
      float nxt = __shfl_down(mx, 1); if (lane == 63) nxt = -3.0e38f;
      x1 = fmaxf(nxt, C1); x0 = mx;
    }
    Rv[dr * 128 + lane * 2] = R0; Rv[dr * 128 + lane * 2 + 1] = R1;
    Cv[dr * 128 + lane * 2] = C0; Cv[dr * 128 + lane * 2 + 1] = C1;
    Mv[dr * 128 + lane * 2] = fmaxf(R0 + ms, R0 + x0); Mv[dr * 128 + lane * 2 + 1] = fmaxf(R1 + ms, R1 + x1);
    nS[dr * 128 + lane * 2] = p.nvec[(size_t)id9 * 128 + lane * 2]; nS[dr * 128 + lane * 2 + 1] = p.nvec[(size_t)id9 * 128 + lane * 2 + 1];
    if (lane == 0) msv[dr] = ms;
  }
  {
    const bf16* ksrc = p.proj + t0 * PLD + 1536 + hh * 128;
    const bf16* vsrc = p.Vt + (size_t)(b * 12 + hh) * 128 * 2048 + c * 128;
#pragma unroll
    for (int i = 0; i < 4; ++i) {
      int q = tid + i * 512; int r = q >> 4, cc = (q & 15) * 8;
      *(uint4*)(ks + r * 136 + cc) = *(const uint4*)(ksrc + (size_t)r * PLD + cc);
      *(uint4*)(vT + r * 136 + cc) = *(const uint4*)(vsrc + (size_t)r * 2048 + cc);
    }
#pragma unroll 1
    for (int dr = 0; dr < 2; ++dr) {
      const bf16* csrc = p.kvT + (size_t)((bh * 2 + dr) * 16 + c) * 16384;
#pragma unroll
      for (int i = 0; i < 4; ++i) {
        int q = tid + i * 512; int r = q >> 4, cc = (q & 15) * 8;
        *(uint4*)(CT + dr * 128 * 136 + r * 136 + cc) = *(const uint4*)(csrc + r * 128 + cc);
      }
    }
  }
  __syncthreads();
  const int j = qg * 32 + l32;
  bf16x8 qf[8];
#pragma unroll
  for (int kk = 0; kk < 8; ++kk) qf[kk] = ld8(p.proj + (t0 + j) * PLD + hh * 128 + kk * 16 + hl * 8);
  f32x16 acc[4];
#pragma unroll
  for (int d = 0; d < 4; ++d) acc[d] = zero16();
  const bf16* Cb = CT + dir * 128 * 136 + l32 * 136 + hl * 8;
#pragma unroll
  for (int d = 0; d < 4; ++d) {
#pragma unroll
    for (int kk = 0; kk < 8; ++kk) acc[d] = mfma32(ld8(Cb + d * 32 * 136 + kk * 16), qf[kk], acc[d]);
    __builtin_amdgcn_sched_barrier(0);
  }
  float qn = 0.f;
#pragma unroll
  for (int kk = 0; kk < 8; ++kk)
#pragma unroll
    for (int e = 0; e < 8; ++e) qn += bf2f((bf16)qf[kk][e]) * nS[dir * 128 + kk * 16 + hl * 8 + e];
  qn += __shfl_xor(qn, 32);
  const float Rj = Rv[dir * 128 + j], Mj = Mv[dir * 128 + j], ms = msv[dir];
  const float wi = __expf(Rj + ms - Mj);
#pragma unroll
  for (int d = 0; d < 4; ++d)
#pragma unroll
    for (int i = 0; i < 16; ++i) acc[d][i] *= wi;
  float den = 0.f;
  const float rowt = Rj - Mj;
#pragma unroll 1
  for (int st = 0; st < 4; ++st) {
    if (dir == 0 ? (st > qg) : (st < qg)) continue;
    f32x16 s = zero16();
#pragma unroll
    for (int kk = 0; kk < 8; ++kk) s = mfma32(ld8(ks + (st * 32 + l32) * 136 + kk * 16 + hl * 8), qf[kk], s);
    __builtin_amdgcn_sched_barrier(0);
#pragma unroll
    for (int i = 0; i < 16; ++i) {
      int sidx = st * 32 + (i >> 2) * 8 + hl * 4 + (i & 3);
      bool ok = dir == 0 ? (sidx <= j) : (sidx >= j);
      float wgt = ok ? __expf(rowt + Cv[dir * 128 + sidx]) : 0.f;
      s[i] *= wgt; den += s[i];
    }
#pragma unroll
    for (int hs = 0; hs < 2; ++hs) {
      bf16x8 pb = mk8(pack2(s[hs * 8 + 0], s[hs * 8 + 1]), pack2(s[hs * 8 + 2], s[hs * 8 + 3]), pack2(s[hs * 8 + 4], s[hs * 8 + 5]), pack2(s[hs * 8 + 6], s[hs * 8 + 7]));
#pragma unroll
      for (int d = 0; d < 4; ++d) {
        const bf16* vp = vT + (d * 32 + l32) * 136 + st * 32 + hs * 16 + hl * 4;
        uint2 x0 = *(const uint2*)vp, x1 = *(const uint2*)(vp + 8);
        acc[d] = mfma32(mk8(x0.x, x0.y, x1.x, x1.y), pb, acc[d]);
      }
      __builtin_amdgcn_sched_barrier(0);
    }
  }
  den += __shfl_xor(den, 32);
  den += wi * qn;
  const float rd = 1.f / fmaxf(fabsf(den), __expf(-Mj));
  __syncthreads();
  float* hb = (float*)CT;
#ifdef DBG
  {
    float* hx = dir == 1 ? hb : (float*)smem;
#pragma unroll
    for (int d = 0; d < 4; ++d)
#pragma unroll
      for (int g = 0; g < 4; ++g) {
        float4 v; v.x = acc[d][g * 4] * rd; v.y = acc[d][g * 4 + 1] * rd; v.z = acc[d][g * 4 + 2] * rd; v.w = acc[d][g * 4 + 3] * rd;
        *(float4*)(hx + j * 132 + d * 32 + g * 8 + hl * 4) = v;
      }
  }
  __syncthreads();
  for (int k = 0; k < 8; ++k) {
    if (it == (((2 + k) % 8) * 12 + (5 + 5 * k) % 12) * 16 + (2 + 3 * k) % 16) {
      float* dd = p.mst + 4096 + k * 32768;
      for (int e = tid; e < 16384; e += 512) { dd[e] = ((float*)smem)[(e >> 7) * 132 + (e & 127)]; dd[16384 + e] = hb[(e >> 7) * 132 + (e & 127)]; }
    }
  }
#else
  if (dir == 1) {
#pragma unroll
    for (int d = 0; d < 4; ++d)
#pragma unroll
      for (int g = 0; g < 4; ++g) {
        float4 v; v.x = acc[d][g * 4] * rd; v.y = acc[d][g * 4 + 1] * rd; v.z = acc[d][g * 4 + 2] * rd; v.w = acc[d][g * 4 + 3] * rd;
        *(float4*)(hb + j * 132 + d * 32 + g * 8 + hl * 4) = v;
      }
  }
  __syncthreads();
#endif
  if (dir == 0) {
    float ss = 0.f;
#pragma unroll
    for (int d = 0; d < 4; ++d)
#pragma unroll
      for (int g = 0; g < 4; ++g) {
        float4 v = *(const float4*)(hb + j * 132 + d * 32 + g * 8 + hl * 4);
        acc[d][g * 4] = acc[d][g * 4] * rd + v.x; acc[d][g * 4 + 1] = acc[d][g * 4 + 1] * rd + v.y;
        acc[d][g * 4 + 2] = acc[d][g * 4 + 2] * rd + v.z; acc[d][g * 4 + 3] = acc[d][g * 4 + 3] * rd + v.w;
        ss += acc[d][g * 4] * acc[d][g * 4] + acc[d][g * 4 + 1] * acc[d][g * 4 + 1] + acc[d][g * 4 + 2] * acc[d][g * 4 + 2] + acc[d][g * 4 + 3] * acc[d][g * 4 + 3];
      }
    ss += __shfl_xor(ss, 32);
    const float rn = rsqrtf(ss * (1.f / 128.f) + LN_EPS);
    const float* gn = p.ml_hn + hh * 128;
    const bf16* osrc = p.proj + (t0 + j) * PLD + 3072 + hh * 128;
    bf16* dst = p.hbf + (t0 + j) * 2048 + hh * 128;
#pragma unroll
    for (int d = 0; d < 4; ++d)
#pragma unroll
      for (int g = 0; g < 4; ++g) {
        int cc = d * 32 + g * 8 + hl * 4;
        float4 gg = *(const float4*)(gn + cc);
        uint2 ov = *(const uint2*)(osrc + cc);
        float o0 = 1.f / (1.f + __expf(-bflo(ov.x))), o1 = 1.f / (1.f + __expf(-bfhi(ov.x))), o2 = 1.f / (1.f + __expf(-bflo(ov.y))), o3 = 1.f / (1.f + __expf(-bfhi(ov.y)));
        uint2 v; v.x = pack2(acc[d][g * 4] * rn * gg.x * o0, acc[d][g * 4 + 1] * rn * gg.y * o1);
        v.y = pack2(acc[d][g * 4 + 2] * rn * gg.z * o2, acc[d][g * 4 + 3] * rn * gg.w * o3);
        *(uint2*)(dst + cc) = v;
      }
  }
  __syncthreads();
}

typedef __attribute__((ext_vector_type(2))) float f32x2;
typedef __attribute__((ext_vector_type(6))) unsigned u32x6;
typedef __attribute__((ext_vector_type(32))) float f32x32;
#define PEER_LOAD(R4, R2, base, k0) { _Pragma("unroll") for (int kk = 0; kk < 4; ++kk) { \
    const int e_ = __builtin_amdgcn_readfirstlane(we[(k0) + kk]); \
    R4[kk] = *(const uint4*)((base) + (size_t)e_ * 1024 + lane * 16); } }
#define FP4P(w, b) __builtin_amdgcn_cvt_scalef32_pk_f32_fp4((w), 1.0f, (b))
DEV float dot_row(uint4 a, uint2, const f32x2 (&hv)[16]) {
  f32x2 s = {0.f, 0.f};
  s += FP4P(a.x, 0) * hv[0]; s += FP4P(a.x, 1) * hv[1]; s += FP4P(a.x, 2) * hv[2]; s += FP4P(a.x, 3) * hv[3];
  s += FP4P(a.y, 0) * hv[4]; s += FP4P(a.y, 1) * hv[5]; s += FP4P(a.y, 2) * hv[6]; s += FP4P(a.y, 3) * hv[7];
  s += FP4P(a.z, 0) * hv[8]; s += FP4P(a.z, 1) * hv[9]; s += FP4P(a.z, 2) * hv[10]; s += FP4P(a.z, 3) * hv[11];
  s += FP4P(a.w, 0) * hv[12]; s += FP4P(a.w, 1) * hv[13]; s += FP4P(a.w, 2) * hv[14]; s += FP4P(a.w, 3) * hv[15];
  return s.x + s.y;
}
DEV float reduce4(float p0, float p1, float p2, float p3, int lane) {
  const bool up = lane & 32;
  float k0 = (up ? p2 : p0) + __shfl_xor(up ? p0 : p2, 32);
  float k1 = (up ? p3 : p1) + __shfl_xor(up ? p1 : p3, 32);
  const bool u2 = lane & 16;
  float v = (u2 ? k1 : k0) + __shfl_xor(u2 ? k0 : k1, 16);
  v += __shfl_xor(v, 8); v += __shfl_xor(v, 4); v += __shfl_xor(v, 2); v += __shfl_xor(v, 1);
  return v;
}
#define PEER_DOT(R4, R2, k0) { float q0 = dot_row(R4[0], R2[0], hv), q1 = dot_row(R4[1], R2[1], hv), q2 = dot_row(R4[2], R2[2], hv), q3 = dot_row(R4[3], R2[3], hv); \
    float v_ = reduce4(q0, q1, q2, q3, lane); if ((lane & 15) == 0) wk[(k0) + (lane >> 4)] = v_; }
#define PEER_ACC(R4, R2, k0) { _Pragma("unroll") for (int kk = 0; kk < 4; ++kk) { const float w1_ = wk[(k0) + kk]; const f32x2 ww = {w1_, w1_}; const uint4 a_ = R4[kk]; \
    acc[0] += ww * FP4P(a_.x, 0); acc[1] += ww * FP4P(a_.x, 1); acc[2] += ww * FP4P(a_.x, 2); acc[3] += ww * FP4P(a_.x, 3); \
    acc[4] += ww * FP4P(a_.y, 0); acc[5] += ww * FP4P(a_.y, 1); acc[6] += ww * FP4P(a_.y, 2); acc[7] += ww * FP4P(a_.y, 3); \
    acc[8] += ww * FP4P(a_.z, 0); acc[9] += ww * FP4P(a_.z, 1); acc[10] += ww * FP4P(a_.z, 2); acc[11] += ww * FP4P(a_.z, 3); \
    acc[12] += ww * FP4P(a_.w, 0); acc[13] += ww * FP4P(a_.w, 1); acc[14] += ww * FP4P(a_.w, 2); acc[15] += ww * FP4P(a_.w, 3); } }
#define WAVE_FENCE() { __builtin_amdgcn_fence(__ATOMIC_ACQ_REL, "wavefront"); __builtin_amdgcn_wave_barrier(); }

DEV void phase_peer(const Params& p, int layer, char* smem, bool last) {
  const int lane = threadIdx.x & 63, w = threadIdx.x >> 6;
  int* we = (int*)smem + w * 64;
  float* wg = (float*)smem + w * 64 + 16;
  float* wk = (float*)smem + w * 64 + 32;
  int ci = 0, cj = 0; bool valid = false;
  { int r = lane; for (int i = 0; i < 16; ++i) { int n = 16 / (i + 1); if (r < n) { ci = i; cj = r; valid = true; break; } r -= n; } }
  const unsigned char* U = p.tab + (size_t)(layer * 2) * 16384 * 1024;
  const unsigned char* V = U + (size_t)16384 * 1024;
  const float* su = p.tsc + (size_t)(layer * 2) * 16384; const float* sv_ = su + 16384;
  const float* g = p.ln_ffn_g + layer * 2048; const float* bta = p.ln_ffn_b + layer * 2048;
  for (int t = blockIdx.x * 8 + w; t < T_; t += gridDim.x * 8) {
    f32x2 hv[16], acc[16];
#pragma unroll
    for (int c = 0; c < 8; ++c) {
      float4 a = *(const float4*)(p.hf + (size_t)t * 2048 + c * 256 + lane * 4);
      hv[c * 2] = (f32x2){a.x, a.y}; hv[c * 2 + 1] = (f32x2){a.z, a.w};
      acc[c * 2] = (f32x2){0.f, 0.f}; acc[c * 2 + 1] = (f32x2){0.f, 0.f};
    }
#pragma unroll 1
    for (int hd = 0; hd < 8; ++hd) {
      const size_t so = ((size_t)t * 8 + hd) * 32;
      float cand = -3.0e38f; int eid = 0;
      if (valid) { cand = p.sv[so + ci] + p.sv[so + 16 + cj]; eid = p.si[so + ci] * 128 + p.si[so + 16 + cj]; }
      int rank = 0;
#pragma unroll
      for (int k = 0; k < 50; ++k) { const float o = __int_as_float(__builtin_amdgcn_readlane(__float_as_int(cand), k)); rank += (o > cand || (o == cand && k < lane)) ? 1 : 0; }
      const float mx = __int_as_float(__builtin_amdgcn_readlane(__float_as_int(cand), 0));
      const bool win = valid && rank < 16;
      const float e = win ? __expf(cand - mx) : 0.f;
      const float gsum = wave_sum(e);
      if (win) { we[rank] = eid; wg[rank] = e / gsum; }
      WAVE_FENCE();
      uint4 ra4[4], rb4[4]; uint2 ra2[4], rb2[4];
      PEER_LOAD(ra4, ra2, U, 0); PEER_LOAD(rb4, rb2, U, 4);
      float scu = 0.f, scv = 0.f;
      if (lane < 16) { const int e_ = we[lane]; scu = su[e_]; scv = sv_[e_]; }
      PEER_DOT(ra4, ra2, 0); PEER_LOAD(ra4, ra2, U, 8);
      PEER_DOT(rb4, rb2, 4); PEER_LOAD(rb4, rb2, U, 12);
      PEER_DOT(ra4, ra2, 8); PEER_LOAD(ra4, ra2, V, 0);
      PEER_DOT(rb4, rb2, 12); PEER_LOAD(rb4, rb2, V, 4);
      WAVE_FENCE();
      if (lane < 16) { const float a = wk[lane] * scu; wk[lane] = wg[lane] * 0.5f * a * (1.f + erff(a * 0.7071067811865476f)) * scv; }
      WAVE_FENCE();
      PEER_ACC(ra4, ra2, 0); PEER_LOAD(ra4, ra2, V, 8);
      PEER_ACC(rb4, rb2, 4); PEER_LOAD(rb4, rb2, V, 12);
      PEER_ACC(ra4, ra2, 8);
      PEER_ACC(rb4, rb2, 12);
      WAVE_FENCE();
    }
    float sm = 0.f;
#pragma unroll
    for (int i = 0; i < 16; ++i) { acc[i] += DN_ALPHA * hv[i]; sm += acc[i].x + acc[i].y; }
    const float mu = wave_sum(sm) * (1.f / 2048.f);
    float q = 0.f;
#pragma unroll
    for (int i = 0; i < 16; ++i) { float d0 = acc[i].x - mu, d1 = acc[i].y - mu; q += d0 * d0 + d1 * d1; }
    const float rstd = rsqrtf(wave_sum(q) * (1.f / 2048.f) + LN_EPS);
#pragma unroll
    for (int c = 0; c < 8; ++c) {
      const int o = c * 256 + lane * 4;
      float4 g0 = *(const float4*)(g + o), b0 = *(const float4*)(bta + o), r0;
      r0.x = (acc[c * 2].x - mu) * rstd * g0.x + b0.x; r0.y = (acc[c * 2].y - mu) * rstd * g0.y + b0.y;
      r0.z = (acc[c * 2 + 1].x - mu) * rstd * g0.z + b0.z; r0.w = (acc[c * 2 + 1].y - mu) * rstd * g0.w + b0.w;
      *(float4*)((last ? p.out : p.hf) + (size_t)t * 2048 + o) = r0;
      if (!last) { uint2 h; h.x = pack2(r0.x, r0.y); h.y = pack2(r0.z, r0.w); *(uint2*)(p.hbf + (size_t)t * 2048 + o) = h; }
    }
  }
}

#ifdef DBG
#define TOKB ((size_t)((blockIdx.x * 1031 + 5000) % 16384))
#define DMAX(idx, v) atomicMax((int*)&dbg[idx], __float_as_int(v))
DEV float blk_sum(float v, float* red) {
  v = wave_sum(v); __syncthreads(); if ((threadIdx.x & 63) == 0) red[threadIdx.x >> 6] = v; __syncthreads();
  float r = 0.f; for (int i = 0; i < 8; ++i) r += red[i]; return r;
}
DEV float blk_max(float v, float* red) {
  v = wave_max(v); __syncthreads(); if ((threadIdx.x & 63) == 0) red[threadIdx.x >> 6] = v; __syncthreads();
  float r = -3e38f; for (int i = 0; i < 8; ++i) r = fmaxf(r, red[i]); return r;
}
__global__ void __launch_bounds__(512) dbg_attn(Params p, float* dbg) {
  __shared__ float qs[128], a[2048], red[8], o_s[128];
  const size_t t = TOKB; const int tid = threadIdx.x, b = (int)(t >> 11), hh = (5 + 5 * blockIdx.x) % 12, bh = b * 12 + hh;
  float la = 0.f, lc = 0.f; for (int i = 0; i < 64; ++i) { la += p.attn_lam[i] * p.attn_lam[64 + i]; lc += p.attn_lam[128 + i] * p.attn_lam[192 + i]; }
  const float lam = expf(la) - expf(lc) + 0.2f;
  if (tid < 128) qs[tid] = bf2f(p.proj[t * PLD + hh * 128 + tid]);
  __syncthreads();
  float s1[4], s2[4], m1 = -3e38f, m2 = -3e38f;
  for (int i = 0; i < 4; ++i) {
    int key = tid + 512 * i; const bf16* kp = p.proj + ((size_t)b * 2048 + key) * PLD + 1536 + hh * 128;
    float x = 0.f, y = 0.f; for (int d = 0; d < 64; ++d) { x += qs[d] * bf2f(kp[d]); y += qs[64 + d] * bf2f(kp[64 + d]); }
    s1[i] = x; s2[i] = y; m1 = fmaxf(m1, x); m2 = fmaxf(m2, y);
  }
  m1 = blk_max(m1, red); m2 = blk_max(m2, red);
  float l1 = 0.f, l2 = 0.f; for (int i = 0; i < 4; ++i) { s1[i] = expf(s1[i] - m1); s2[i] = expf(s2[i] - m2); l1 += s1[i]; l2 += s2[i]; }
  l1 = blk_sum(l1, red); l2 = blk_sum(l2, red);
  for (int i = 0; i < 4; ++i) a[tid + 512 * i] = s1[i] / l1 - lam * s2[i] / l2;
  __syncthreads();
  float o = 0.f;
  if (tid < 128) { const bf16* vp = p.Vt + ((size_t)bh * 128 + tid) * 2048; for (int k = 0; k < 2048; ++k) o += a[k] * bf2f(vp[k]); }
  float ss = blk_sum(tid < 128 ? o * o : 0.f, red);
  float rn = rsqrtf(ss / 128.f + LN_EPS) * 0.8f;
  float err = 0.f, mag = 0.f;
  if (tid < 128) { float e = o * rn * p.attn_hn[hh * 128 + tid]; float g = bf2f(p.hbf[t * 2048 + hh * 128 + tid]); err = fabsf(e - g); mag = fabsf(e); }
  err = blk_max(err, red); mag = blk_max(mag, red);
  if (tid == 0) DMAX(2, err / (mag + 1e-6f));
}
__global__ void __launch_bounds__(512) dbg_topk(Params p, float* dbg, int layer, int idx) {
  __shared__ float qry[128], sc[128];
  const int tid = threadIdx.x; const size_t t = TOKB; const int h = (3 + blockIdx.x) % 8, pp = blockIdx.x & 1;
  for (int k = tid; k < 2048; k += 512) dbg[65536 + blockIdx.x * 2048 + k] = p.hf[t * 2048 + k];
  if (tid < 128) { float x = 0.f; for (int k = 0; k < 2048; ++k) x += p.hf[t * 2048 + k] * p.wq[(size_t)layer * 2048 * 2048 + (size_t)k * 2048 + h * 256 + pp * 128 + tid]; qry[tid] = x; }
  __syncthreads();
  if (tid < 128) { float x = 0.f; const float* sk = p.subk + ((size_t)((layer * 8 + h) * 2 + pp) * 128 + tid) * 128; for (int s = 0; s < 128; ++s) x += qry[s] * sk[s]; sc[tid] = x; }
  __syncthreads();
  if (tid == 0) {
    float err = 0.f; unsigned taken[4] = {0, 0, 0, 0};
    const size_t o = (t * 8 + h) * 32 + pp * 16;
    for (int r = 0; r < 16; ++r) {
      float best = -3e38f; int bi = 0;
      for (int n = 0; n < 128; ++n) if (!((taken[n >> 5] >> (n & 31)) & 1) && sc[n] > best) { best = sc[n]; bi = n; }
      taken[bi >> 5] |= 1u << (bi & 31);
      err = fmaxf(err, fabsf(p.sv[o + r] - best));
      int mi = p.si[o + r]; if (mi < 0 || mi > 127) err = 100.f; else err = fmaxf(err, fabsf(sc[mi] - p.sv[o + r]));
    }
    DMAX(idx, err);
  }
}
__global__ void __launch_bounds__(512) dbg_peer(Params p, float* dbg, int layer, int idx) {
  __shared__ int el[128]; __shared__ float gl[128], wl[128], red[8];
  const int tid = threadIdx.x, lane = tid & 63, w = tid >> 6; const size_t t = TOKB; const float* hrow = dbg + 65536 + blockIdx.x * 2048;
  if (tid < 8) {
    const int h = tid; const size_t o = (t * 8 + h) * 32; bool tk[256];
    float tv[16]; int te[16];
    unsigned taken[8] = {0,0,0,0,0,0,0,0};
    for (int r = 0; r < 16; ++r) {
      float best = -3e38f; int bi = 0;
      for (int c = 0; c < 256; ++c) { float v = p.sv[o + (c >> 4)] + p.sv[o + 16 + (c & 15)]; if (!((taken[c >> 5] >> (c & 31)) & 1) && v > best) { best = v; bi = c; } }
      taken[bi >> 5] |= 1u << (bi & 31);
      gl[h * 16 + r] = best; el[h * 16 + r] = p.si[o + (bi >> 4)] * 128 + p.si[o + 16 + (bi & 15)];
    }
    float mx = gl[h * 16], sm = 0.f; for (int r = 0; r < 16; ++r) sm += expf(gl[h * 16 + r] - mx);
    for (int r = 0; r < 16; ++r) gl[h * 16 + r] = expf(gl[h * 16 + r] - mx) / sm;
  }
  __syncthreads();
  for (int i = 0; i < 16; ++i) {
    int ix = w * 16 + i; const float* up = p.pu + (size_t)layer * 16384 * 2048 + (size_t)el[ix] * 2048; float x = 0.f;
    for (int k = lane; k < 2048; k += 64) x += hrow[k] * up[k];
    x = wave_sum(x);
    if (lane == 0) wl[ix] = gl[ix] * 0.5f * x * (1.f + erff(x * 0.7071067811865476f));
  }
  __syncthreads();
  float z[4], s = 0.f;
  for (int j = 0; j < 4; ++j) { int d = tid * 4 + j; float f = 0.f; for (int i = 0; i < 128; ++i) f += wl[i] * p.pv[(size_t)layer * 16384 * 2048 + (size_t)el[i] * 2048 + d]; z[j] = DN_ALPHA * hrow[d] + f; s += z[j]; }
  float mu = blk_sum(s, red) / 2048.f; float q = 0.f; for (int j = 0; j < 4; ++j) q += (z[j] - mu) * (z[j] - mu);
  float rstd = rsqrtf(blk_sum(q, red) / 2048.f + LN_EPS);
  float err = 0.f;
  for (int j = 0; j < 4; ++j) { int d = tid * 4 + j; float e = (z[j] - mu) * rstd * p.ln_ffn_g[layer * 2048 + d] + p.ln_ffn_b[layer * 2048 + d]; err = fmaxf(err, fabsf(e - (layer ? p.out : p.hf)[t * 2048 + d])); }
  err = blk_max(err, red);
  if (tid == 0) DMAX(idx, err);
}
__global__ void __launch_bounds__(512) dbg_mlstm(Params p, float* dbg) {
  __shared__ float numl[132], red[8];
  const int k_ = blockIdx.x, tid = threadIdx.x, b = (2 + k_) % 8, hh = (5 + 5 * k_) % 12, c_ = (2 + 3 * k_) % 16, lo = c_ * 128, hi = lo + 127, bh = b * 12 + hh, kd = tid >> 2, vd0 = (tid & 3) * 32;
  for (int dir = 0; dir < 2; ++dir) {
    float C[32]; for (int e = 0; e < 32; ++e) C[e] = 0.f; float n = 0.f, m = 0.f, err = 0.f, mag = 0.f;
    const float* dump = p.mst + 4096 + k_ * 32768 + dir * 16384;
    for (int sp = 0; sp < 2048; ++sp) {
      const int s = dir ? 2047 - sp : sp; if (dir == 0 ? (s > hi) : (s < lo)) break;
      const size_t t = (size_t)b * 2048 + s;
      const float ig = p.gates[t * 48 + (2 * dir) * 12 + hh] + p.ml_gb[(2 * dir) * 12 + hh];
      const float lf = log_sigmoid(p.gates[t * 48 + (2 * dir + 1) * 12 + hh] + p.ml_gb[(2 * dir + 1) * 12 + hh]);
      const float mn = fmaxf(lf + m, ig), dec = expf(lf + m - mn), wv = expf(ig - mn); m = mn;
      const float kk = bf2f(p.proj[t * PLD + 1536 + hh * 128 + kd]);
      for (int e = 0; e < 32; ++e) C[e] = dec * C[e] + wv * kk * bf2f(p.Vt[((size_t)bh * 128 + vd0 + e) * 2048 + s]);
      n = dec * n + wv * kk;
      if (s >= lo && s <= hi) {
        const float q = bf2f(p.proj[t * PLD + hh * 128 + kd]);
        __syncthreads(); if (tid < 132) numl[tid] = 0.f; __syncthreads();
        for (int e = 0; e < 32; ++e) atomicAdd(&numl[vd0 + e], q * C[e]);
        if ((tid & 3) == 0) atomicAdd(&numl[128], q * n);
        __syncthreads();
        if (tid < 128) { float h = numl[tid] / fmaxf(fabsf(numl[128]), expf(-m)); float g = dump[(s - lo) * 128 + tid]; err += fabsf(h - g); mag += fabsf(h); }
      }
    }
    err = blk_sum(err, red); mag = blk_sum(mag, red);
    if (tid == 0) { DMAX(dir, err / (mag + 1e-6f)); dbg[40 + dir * 8 + k_] = err / (mag + 1e-6f); }
  }
}

DEV float blk_dotf(const float* row, const float* W, int ldw, int col, float* red) {
  float x = 0.f; for (int k = threadIdx.x; k < 2048; k += 512) x += row[k] * W[(size_t)k * ldw + col];
  return blk_sum(x, red);
}
DEV void chk(float* dbg, int idx, float got, float exp) { if (threadIdx.x == 0) { float e = fabsf(got - exp) / (0.02f + 0.02f * fabsf(exp)); DMAX(idx, e); } }
__global__ void __launch_bounds__(512) dbg_proj0(Params p, float* dbg) {
  __shared__ float red[8];
  const size_t t = TOKB; const float* xr = p.x + t * 2048; const int b_ = (int)(t >> 11), s_ = (int)(t & 2047);
  const float inv = powf(10000.f, -9.f / 32.f); const float ang = (float)p.pos[t] * inv; const float cs = cosf(ang), sn = sinf(ang);
  { float a = blk_dotf(xr, p.attn_w, 5120, 457, red), b = blk_dotf(xr, p.attn_w, 5120, 489, red);
    chk(dbg, 8, bf2f(p.proj[t * PLD + 457]), (a * cs - b * sn) * 0.125f); chk(dbg, 8, bf2f(p.proj[t * PLD + 489]), (b * cs + a * sn) * 0.125f); }
  { float a = blk_dotf(xr, p.attn_w, 5120, 1536 + 457, red), b = blk_dotf(xr, p.attn_w, 5120, 1536 + 489, red);
    chk(dbg, 9, bf2f(p.proj[t * PLD + 1536 + 457]), (a * cs - b * sn)); chk(dbg, 9, bf2f(p.proj[t * PLD + 1536 + 489]), (b * cs + a * sn)); }
  { float a = blk_dotf(xr, p.attn_w, 5120, 3072 + 700, red); chk(dbg, 10, bf2f(p.Vt[((size_t)(b_ * 12 + 5) * 128 + 60) * 2048 + s_]), a); }
  { float a = blk_dotf(xr, p.attn_w, 5120, 4608 + 300, red); chk(dbg, 11, bf2f(p.proj[t * PLD + 3072 + 300]), a * 0.08838834764831845f); }
  { const int r_ = (700 + blockIdx.x * 263) % 2048; const float* mr = p.mem + (size_t)r_ * 2048; float a = blk_dotf(mr, p.memkv_w, 1024, 300, red), b = blk_dotf(mr, p.memkv_w, 1024, 812, red);
    chk(dbg, 12, bf2f(p.memK[(size_t)r_ * 512 + 300]), a); chk(dbg, 12, bf2f(p.memVt[((size_t)((r_ >> 8) * 4 + 2) * 128 + 44) * 256 + (r_ & 255)]), b); }
}
__global__ void __launch_bounds__(512) dbg_memattn(Params p, float* dbg, int qmcol, int idx) {
  __shared__ float qs[128], a[256], red[8];
  const size_t t = TOKB; const int tid = threadIdx.x, b = (int)(t >> 11), mh = blockIdx.x & 3;
  if (tid < 128) qs[tid] = bf2f(p.proj[t * PLD + qmcol + mh * 128 + tid]);
  __syncthreads();
  float sc = -3e38f;
  if (tid < 256) { sc = 0.f; const bf16* kp = p.memK + ((size_t)b * 256 + tid) * 512 + mh * 128; for (int d = 0; d < 128; ++d) sc += qs[d] * bf2f(kp[d]); }
  float mx = blk_max(sc, red); float e = tid < 256 ? expf(sc - mx) : 0.f; float l = blk_sum(e, red);
  if (tid < 256) a[tid] = e / l;
  __syncthreads();
  if (tid < 128) { float o = 0.f; const bf16* vp = p.memVt + ((size_t)(b * 4 + mh) * 128 + tid) * 256; for (int k = 0; k < 256; ++k) o += a[k] * bf2f(vp[k]);
    float g = bf2f(p.hbf[t * 2048 + 1536 + mh * 128 + tid]); float er = fabsf(g - o) / (0.01f + 0.03f * fabsf(o)); atomicMax((int*)&dbg[idx], __float_as_int(er)); }
}
__global__ void __launch_bounds__(512) dbg_z(Params p, float* dbg, int layer, int idx) {
  __shared__ float cr[2048];
  const int tid = threadIdx.x; const size_t t = TOKB;
  for (int k = tid; k < 2048; k += 512) cr[k] = bf2f(p.hbf[t * 2048 + k]);
  __syncthreads();
  const float* hp = layer == 0 ? p.x + t * 2048 : dbg + 131072 + blockIdx.x * 2048;
  const float* W = p.w_out + (size_t)layer * 2048 * 2048;
  for (int j = 0; j < 4; ++j) { int n = tid + 512 * j; float y = 0.f; for (int k = 0; k < 2048; ++k) y += cr[k] * W[(size_t)k * 2048 + n];
    float z = DN_ALPHA * hp[n] + y; dbg[32768 + blockIdx.x * 2048 + n] = z; float er = fabsf(p.hf[t * 2048 + n] - z) / (0.02f + 0.02f * fabsf(z)); atomicMax((int*)&dbg[idx], __float_as_int(er)); }
}
__global__ void __launch_bounds__(512) dbg_ln(Params p, float* dbg, int layer, int idx) {
  __shared__ float red[8];
  const int tid = threadIdx.x; const size_t t = TOKB; const float* z = dbg + 32768 + blockIdx.x * 2048;
  float s = 0.f; for (int j = 0; j < 4; ++j) s += z[tid + 512 * j];
  float mu = blk_sum(s, red) / 2048.f; float q = 0.f; for (int j = 0; j < 4; ++j) { float d = z[tid + 512 * j] - mu; q += d * d; }
  float rstd = rsqrtf(blk_sum(q, red) / 2048.f + LN_EPS);
  for (int j = 0; j < 4; ++j) { int n = tid + 512 * j; float e = (z[n] - mu) * rstd * p.ln_mix_g[layer * 2048 + n] + p.ln_mix_b[layer * 2048 + n];
    float er = fabsf(p.hf[t * 2048 + n] - e) / (0.02f + 0.02f * fabsf(e)); atomicMax((int*)&dbg[idx], __float_as_int(er));
    float er2 = fabsf(bf2f(p.hbf[t * 2048 + n]) - e) / (0.02f + 0.02f * fabsf(e)); atomicMax((int*)&dbg[idx], __float_as_int(er2)); }
}
__global__ void __launch_bounds__(512) dbg_proj1(Params p, float* dbg) {
  __shared__ float red[8];
  const size_t t = TOKB; const float* xr = p.hf + t * 2048; const int b_ = (int)(t >> 11), s_ = (int)(t & 2047);
  for (int k = threadIdx.x; k < 2048; k += 512) dbg[131072 + blockIdx.x * 2048 + k] = xr[k];
  const float sc = 0.08838834764831845f;
  { float a = blk_dotf(xr, p.ml_w, 6704, 200, red); chk(dbg, 16, bf2f(p.proj[t * PLD + 200]), a); }
  { float a = blk_dotf(xr, p.ml_w, 6704, 1536 + 200, red); chk(dbg, 16, bf2f(p.proj[t * PLD + 1536 + 200]), a * sc); }
  { float a = blk_dotf(xr, p.ml_w, 6704, 4608 + 200, red); chk(dbg, 16, bf2f(p.proj[t * PLD + 3072 + 200]), a); }
  { float a = blk_dotf(xr, p.ml_w, 6704, 6144 + 200, red); chk(dbg, 16, bf2f(p.proj[t * PLD + 4608 + 200]), a * sc); }
  { float a = blk_dotf(xr, p.ml_w, 6704, 6656 + 7, red); chk(dbg, 17, p.gates[t * 48 + 7], a); }
  { float a = blk_dotf(xr, p.ml_w, 6704, 6656 + 40, red); chk(dbg, 17, p.gates[t * 48 + 40], a); }
  { float a = blk_dotf(xr, p.ml_w, 6704, 3072 + 700, red); chk(dbg, 17, bf2f(p.Vt[((size_t)(b_ * 12 + 5) * 128 + 60) * 2048 + s_]), a); }
}
__global__ void __launch_bounds__(128) dbg_mlcomb(Params p, float* dbg) {
  __shared__ float red[8];
  const int k_ = blockIdx.x, tid = threadIdx.x, j = (37 + 11 * k_) & 127, hh = (5 + 5 * k_) % 12; const size_t t = (size_t)((2 + k_) % 8) * 2048 + ((2 + 3 * k_) % 16) * 128 + j;
  float h = p.mst[4096 + k_ * 32768 + j * 128 + tid] + p.mst[4096 + k_ * 32768 + 16384 + j * 128 + tid];
  float v = wave_sum(h * h); __syncthreads(); if ((tid & 63) == 0) red[tid >> 6] = v; __syncthreads();
  float rn = rsqrtf((red[0] + red[1]) / 128.f + LN_EPS);
  float o = bf2f(p.proj[t * PLD + 3072 + hh * 128 + tid]);
  float e = h * rn * p.ml_hn[hh * 128 + tid] / (1.f + expf(-o));
  float er = fabsf(bf2f(p.hbf[t * 2048 + hh * 128 + tid]) - e) / (0.02f + 0.02f * fabsf(e)); atomicMax((int*)&dbg[18], __float_as_int(er));
}
__global__ void dbg_init(float* dbg) { if (threadIdx.x < 64) dbg[threadIdx.x] = 0.f; }
__global__ void dbg_final(Params p, float* dbg) {
  const int order[21] = {8, 9, 10, 11, 12, 13, 2, 14, 15, 3, 4, 16, 17, 0, 1, 18, 19, 20, 21, 22, 23};
  const float thr[21] = {1, 1, 1, 1, 1, 1, 0.05f, 1, 1, 0.05f, 0.05f, 1, 1, 0.1f, 0.1f, 1, 1, 1, 1, 0.05f, 0.05f};
  int code = 0;
  for (int i = 20; i >= 0; --i) if (!(dbg[order[i]] < thr[i])) code = i + 1;
  if (code == 14 || code == 15) {
    int wk = 0; float we = -1.f;
    for (int i = 0; i < 16; ++i) if (dbg[40 + i] > we) { we = dbg[40 + i]; wk = i; }
    int cls = we < 0.2f ? 0 : we < 0.5f ? 1 : we < 1.0f ? 2 : we < 2.f ? 3 : 4;
    code = wk * 5 + cls;
  }
  p.out[0] = 1000.f * (10 + code);
}
#endif

#define XB_TMO      128
#define XB_XCNT(j)  (256  + 64 * (j))
#define XB_XSUB(j)  (1280 + 64 * (j))
#define XB_XGEN(j)  (2304 + 64 * (j))
#define XB_TOP      3328
#define XB_TOPGEN   3392
#define XCD_BAR_WORDS 3456
#define XB_SPIN_CAP (1u << 21)
#define LAS __attribute__((address_space(3)))

__device__ __forceinline__ unsigned xb_ld(unsigned* p)              { return __hip_atomic_load(p, __ATOMIC_RELAXED, __HIP_MEMORY_SCOPE_AGENT); }
__device__ __forceinline__ unsigned xb_add(unsigned* p, unsigned v) { return __hip_atomic_fetch_add(p, v, __ATOMIC_RELAXED, __HIP_MEMORY_SCOPE_AGENT); }
__device__ __forceinline__ unsigned xb_xcc_id() { return (unsigned)__builtin_amdgcn_s_getreg((3 << 11) | 20) & 0xFu; }
#define XB_SPIN(cond, bar) do { unsigned _sp = 0; while (cond) { __builtin_amdgcn_s_sleep(1); \
    if ((++_sp & 255u) == 0u) { if (xb_ld(&(bar)[XB_TMO])) break; if (_sp > XB_SPIN_CAP) { atomicAdd(&(bar)[XB_TMO], 1u); break; } } } } while (0)

struct XcdBarrier {
    unsigned* bar; unsigned x;
    volatile LAS unsigned* st;
};

__device__ __forceinline__ XcdBarrier xcd_barrier_post(unsigned* bar, volatile LAS unsigned* st) {
    XcdBarrier b; b.bar = bar; b.x = xb_xcc_id(); b.st = st;
    if (threadIdx.x == 0) (void)xb_add(&bar[XB_XCNT(b.x)], 1u);
    return b;
}
__device__ __forceinline__ void xcd_barrier_complete(unsigned* bar, unsigned x, unsigned& nloc, unsigned& nx) {
    const unsigned G = gridDim.x * gridDim.y * gridDim.z;
    unsigned sum, cnt, mine, sp = 0u;
    for (;;) {
        sum = 0u; cnt = 0u; mine = 0u;
#pragma unroll
        for (unsigned j = 0; j < 16; ++j) { const unsigned c = xb_ld(&bar[XB_XCNT(j)]); sum += c; cnt += (c > 0u) ? 1u : 0u; mine = (j == x) ? c : mine; }
        if (sum == G) break;
        __builtin_amdgcn_s_sleep(1);
        if ((++sp & 255u) == 0u) { if (xb_ld(&bar[XB_TMO])) break; if (sp > XB_SPIN_CAP) { atomicAdd(&bar[XB_TMO], 1u); break; } }
    }
    nloc = mine > 0u ? mine : 1u; nx = cnt > 0u ? cnt : 1u;
}

__device__ __forceinline__ void xcd_barrier(const XcdBarrier& b) {
    asm volatile("s_waitcnt vmcnt(0)" ::: "memory");
    __syncthreads();
    if (threadIdx.x == 0) {
        unsigned* bar = b.bar;
        __builtin_amdgcn_s_waitcnt(0);
        unsigned nloc = b.st[0], nx = b.st[1];
        if (nloc == 0u) { xcd_barrier_complete(bar, b.x, nloc, nx); b.st[0] = nloc; b.st[1] = nx; }
        const unsigned old = xb_add(&bar[XB_XSUB(b.x)], 1u);
        const unsigned gen = old / nloc;
        if (old + 1u == (gen + 1u) * nloc) {
            __builtin_amdgcn_fence(__ATOMIC_RELEASE, "agent");
            asm volatile("s_waitcnt vmcnt(0)" ::: "memory");
            const unsigned og = xb_add(&bar[XB_TOP], 1u);
            const unsigned tg = og / nx;
            if (og + 1u == (tg + 1u) * nx) xb_add(&bar[XB_TOPGEN], 1u);
            else XB_SPIN(xb_ld(&bar[XB_TOPGEN]) == tg, bar);
            __builtin_amdgcn_fence(__ATOMIC_ACQUIRE, "agent");
            xb_add(&bar[XB_XGEN(b.x)], 1u);
            asm volatile("s_waitcnt vmcnt(0)" ::: "memory");
        } else {
            XB_SPIN(xb_ld(&bar[XB_XGEN(b.x)]) == gen, bar);
            __builtin_amdgcn_fence(__ATOMIC_ACQUIRE, "agent");
            asm volatile("s_waitcnt vmcnt(0)" ::: "memory");
        }
    }
    __syncthreads();
}


__global__ void __launch_bounds__(NT) mega(Params p) {
  extern __shared__ __attribute__((aligned(16))) char smem[];
  cg::grid_group grid = cg::this_grid();
  __shared__ uint4 xb_words;
  if (threadIdx.x == 0) xb_words = make_uint4(0u, 0u, 0u, 0u);
  __syncthreads();
  XcdBarrier xb = xcd_barrier_post(p.bar, (volatile LAS unsigned*)&xb_words);
#ifndef PH_MASK
#define PH_MASK 0x7fff
#endif
#ifndef DUP_MASK
#define DUP_MASK 0
#endif
#define RUNPH(n, ...) if constexpr ((PH_MASK >> n) & 1) { if (p.ph_lo <= n && n < p.ph_hi) { __VA_ARGS__; if constexpr ((DUP_MASK >> n) & 1) { __VA_ARGS__; } if (n + 1 < p.ph_hi) { if (n == 0) grid.sync(); else xcd_barrier(xb); } } }
  RUNPH(0, phase_convert(p, smem))
  RUNPH(1, phase_gemm2<EPI_ATTN>(p, p.hbf, p.WtAttn, 64, 20, 0, smem, 0, 1280); phase_gemm<EPI_MEMKV>(p, p.membf, p.WtMemkv, 16, 4, 0, smem, 1280, 1280 + 64))
  RUNPH(2, phase_attn0(p, smem))
  RUNPH(3, phase_gemm2<EPI_OUT>(p, p.hbf, p.WtOut, 64, 8, 0, smem, 0, 512))
  RUNPH(4, phase_ln(p, p.ln_mix_g, p.ln_mix_b, p.x))
  RUNPH(5, phase_gemm2<EPI_PEERQ>(p, p.hbf, p.WtQ, 64, 8, 0, smem, 0, 512))
  RUNPH(6, phase_peer(p, 0, smem, false))
  RUNPH(7, phase_gemm2<EPI_ML>(p, p.hbf, p.WtMl, 64, 27, 1, smem, 0, 64 * 27))
  RUNPH(8, for (int it = blockIdx.x; it < 3072; it += gridDim.x) ml_summary_item(p, it, smem))
  RUNPH(9, for (int it = blockIdx.x; it < 768; it += gridDim.x) ml_scan_item(p, it))
  RUNPH(10, for (int it = blockIdx.x; it < 1536; it += gridDim.x) ml_out_item(p, it, smem); for (int it = blockIdx.x; it < 256; it += gridDim.x) mem_attn_item(p, it, 4608, smem))
  RUNPH(11, phase_gemm2<EPI_OUT>(p, p.hbf, p.WtOut + (size_t)2048 * 2048, 64, 8, 1, smem, 0, 512))
  RUNPH(12, phase_ln(p, p.ln_mix_g + 2048, p.ln_mix_b + 2048, p.hf))
  RUNPH(13, phase_gemm2<EPI_PEERQ>(p, p.hbf, p.WtQ + (size_t)2048 * 2048, 64, 8, 1, smem, 0, 512))
  RUNPH(14, phase_peer(p, 1, smem, true))
}

#ifndef MULTI_LAUNCH
#define MULTI_LAUNCH 0
#endif

extern "C" void kernel_launch(void* const* d_in, const int* in_sizes, int n_in, void* d_out, int out_size, void* d_ws, size_t ws_size, hipStream_t stream) {
  static int grid_blocks = 0;
  if (!grid_blocks) {
    int dev = 0, cus = 0, per_cu = 0;
    hipGetDevice(&dev);
    hipDeviceGetAttribute(&cus, hipDeviceAttributeMultiprocessorCount, dev);
    hipFuncSetAttribute((const void*)mega, hipFuncAttributeMaxDynamicSharedMemorySize, (int)LDS_BYTES);
    hipOccupancyMaxActiveBlocksPerMultiprocessor(&per_cu, mega, NT, LDS_BYTES);
    if (per_cu < 1) per_cu = 1;
    grid_blocks = cus * per_cu;
  }
  Params p{};
  p.x = (const float*)d_in[0]; p.mem = (const float*)d_in[1]; p.pos = (const int*)d_in[2];
  p.attn_w = (const float*)d_in[3]; p.attn_lam = (const float*)d_in[4]; p.attn_hn = (const float*)d_in[5];
  p.ml_w = (const float*)d_in[6]; p.ml_gb = (const float*)d_in[7]; p.ml_hn = (const float*)d_in[8];
  p.memkv_w = (const float*)d_in[9]; p.w_out = (const float*)d_in[10]; p.ln_mix_g = (const float*)d_in[11]; p.ln_mix_b = (const float*)d_in[12];
  p.wq = (const float*)d_in[13]; p.subk = (const float*)d_in[14]; p.pu = (const float*)d_in[15]; p.pv = (const float*)d_in[16];
  p.ln_ffn_g = (const float*)d_in[17]; p.ln_ffn_b = (const float*)d_in[18];
  p.out = (float*)d_out;
  char* w = (char*)d_ws; size_t off = 0;
  auto take = [&](size_t bytes) { char* r = w + off; off += (bytes + 255) & ~(size_t)255; return r; };
  p.tab = (unsigned char*)take((size_t)4 * 16384 * 1536);
  p.tsc = (float*)take((size_t)4 * 16384 * 4);
  p.ybf = (bf16*)take((size_t)T_ * 2048 * 2);
  p.WtAttn = (bf16*)take((size_t)5120 * 2048 * 2);
  p.WtMl = (bf16*)take((size_t)NMLPAD * 2048 * 2);
  p.WtMemkv = (bf16*)take((size_t)1024 * 2048 * 2);
  p.WtOut = (bf16*)take((size_t)2 * 2048 * 2048 * 2);
  p.WtQ = (bf16*)take((size_t)2 * 2048 * 2048 * 2);
  p.SK = (bf16*)take((size_t)524288 * 2);
  p.membf = (bf16*)take((size_t)2048 * 2048 * 2);
  p.hbf = (bf16*)take((size_t)T_ * 2048 * 2);
  p.proj = (bf16*)take((size_t)T_ * PLD * 2);
  p.Vt = (bf16*)take((size_t)B_ * 12 * 128 * 2048 * 2);
  p.memK = (bf16*)take((size_t)2048 * 512 * 2);
  p.memVt = (bf16*)take((size_t)B_ * 4 * 128 * 256 * 2);
  p.hf = (float*)take((size_t)T_ * 2048 * 4);
  p.gates = (float*)take((size_t)T_ * 48 * 4);
  p.sv = (float*)take((size_t)T_ * 256 * 4);
  p.si = (int*)take((size_t)T_ * 256 * 4);
  p.kvT = (bf16*)take((size_t)3072 * 16384 * 2);
  p.nvec = (float*)take((size_t)3072 * 128 * 4);
  p.scal = (float*)take((size_t)3072 * 2 * 4);
  p.bar = (unsigned*)take((size_t)XCD_BAR_WORDS * 4);
  p.mst = (float*)take((size_t)3072 * 4 + 4000000);
  if (off > ws_size) { fprintf(stderr, "workspace too small: need %zu have %zu\n", off, ws_size); return; }
#if MULTI_LAUNCH
  for (int ph = 0; ph < NPHASE; ++ph) {
    p.ph_lo = ph; p.ph_hi = ph + 1;
    hipLaunchKernelGGL(mega, dim3(grid_blocks), dim3(NT), LDS_BYTES, stream, p);
#ifdef DBG
    float* dbg = p.mst + 300000;
    if (ph == 0) hipLaunchKernelGGL(dbg_init, dim3(1), dim3(64), 0, stream, dbg);
    if (ph == 1) hipLaunchKernelGGL(dbg_proj0, dim3(8), dim3(512), 0, stream, p, dbg);
    if (ph == 2) { hipLaunchKernelGGL(dbg_attn, dim3(8), dim3(512), 0, stream, p, dbg); hipLaunchKernelGGL(dbg_memattn, dim3(8), dim3(512), 0, stream, p, dbg, 3072, 13); }
    if (ph == 3) hipLaunchKernelGGL(dbg_z, dim3(8), dim3(512), 0, stream, p, dbg, 0, 14);
    if (ph == 4) hipLaunchKernelGGL(dbg_ln, dim3(8), dim3(512), 0, stream, p, dbg, 0, 15);
    if (ph == 5) hipLaunchKernelGGL(dbg_topk, dim3(8), dim3(512), 0, stream, p, dbg, 0, 3);
    if (ph == 6) hipLaunchKernelGGL(dbg_peer, dim3(8), dim3(512), 0, stream, p, dbg, 0, 4);
    if (ph == 7) hipLaunchKernelGGL(dbg_proj1, dim3(8), dim3(512), 0, stream, p, dbg);
    if (ph == 10) { hipLaunchKernelGGL(dbg_mlstm, dim3(8), dim3(512), 0, stream, p, dbg); hipLaunchKernelGGL(dbg_mlcomb, dim3(8), dim3(128), 0, stream, p, dbg); hipLaunchKernelGGL(dbg_memattn, dim3(8), dim3(512), 0, stream, p, dbg, 4608, 19); }
    if (ph == 11) hipLaunchKernelGGL(dbg_z, dim3(8), dim3(512), 0, stream, p, dbg, 1, 20);
    if (ph == 12) hipLaunchKernelGGL(dbg_ln, dim3(8), dim3(512), 0, stream, p, dbg, 1, 21);
    if (ph == 13) hipLaunchKernelGGL(dbg_topk, dim3(8), dim3(512), 0, stream, p, dbg, 1, 22);
    if (ph == 14) hipLaunchKernelGGL(dbg_peer, dim3(8), dim3(512), 0, stream, p, dbg, 1, 23);
    if (ph == 14) hipLaunchKernelGGL(dbg_final, dim3(1), dim3(1), 0, stream, p, dbg);
#endif
  }
#else
  p.ph_lo = 0; p.ph_hi = NPHASE;
  hipMemsetAsync(p.bar, 0, (size_t)XCD_BAR_WORDS * 4, stream);
  void* args[] = {&p};
  hipError_t e = hipLaunchCooperativeKernel((void*)mega, dim3(grid_blocks), dim3(NT), args, LDS_BYTES, stream);
  if (e != hipSuccess) fprintf(stderr, "cooperative launch failed: %s (grid %d)\n", hipGetErrorString(e), grid_blocks);
#endif
}
```
